# Optimizing an MI355X kernel written in HIP

```python
import math
import jax, jax.numpy as jnp
from jax import lax
import numpy as np

D_MODEL = 1024
BATCH = 8
SEQ = 4096
DEPTH = 2

CHUNK = 64
Q_BLOCK = 128
RMS_EPS = 1e-6
ROPE_THETA = 500000.0

DIFF_HEADS = 4
DIFF_QK_DIM = 64
DIFF_V_DIM = 2 * DIFF_QK_DIM
DIFF_ROT_DIM = DIFF_QK_DIM // 4

MLA_HEADS = 4
MLA_Q_LORA = 256
MLA_KV_LORA = 128
MLA_NOPE_DIM = 64
MLA_ROPE_DIM = 32
MLA_V_DIM = 64

SB_HEADS = 4
SB_DIM = 64

D_FF = 2816

DIFF_COLS = DIFF_HEADS * (4 * DIFF_QK_DIM + DIFF_V_DIM)
MLA_COLS = MLA_Q_LORA + MLA_KV_LORA + MLA_ROPE_DIM
SB_COLS = 3 * SB_HEADS * SB_DIM
IN_COLS = DIFF_COLS + MLA_COLS + SB_COLS
D_MIX = DIFF_HEADS * DIFF_V_DIM + MLA_HEADS * MLA_V_DIM + SB_HEADS * SB_DIM
MLA_UQ_COLS = MLA_HEADS * (MLA_NOPE_DIM + MLA_ROPE_DIM)
MLA_UKV_COLS = MLA_HEADS * (MLA_NOPE_DIM + MLA_V_DIM)

kernel_name = 'hymba_diff_mla_stickbreaking_macaron'


def rms_norm(x, g):
    xf = x.astype(jnp.float32)
    y = xf * lax.rsqrt(jnp.mean(xf * xf, axis=-1, keepdims=True) + RMS_EPS)
    return (y * g.astype(jnp.float32)).astype(x.dtype)


def swiglu(h, w_gate, w_up, w_down):
    return (jax.nn.silu(h @ w_gate) * (h @ w_up)) @ w_down


def rope_tables(rot_dim, seq):
    inv = ROPE_THETA ** (-jnp.arange(0, rot_dim, 2, dtype=jnp.float32) / rot_dim)
    ang = jnp.arange(seq, dtype=jnp.float32)[:, None] * inv[None, :]
    return jnp.cos(ang), jnp.sin(ang)


def apply_rope(x, cos, sin):
    shape = (1, cos.shape[0]) + (1,) * (x.ndim - 3) + (cos.shape[1],)
    c = cos.reshape(shape)
    s = sin.reshape(shape)
    half = x.shape[-1] // 2
    x1, x2 = x[..., :half], x[..., half:]
    return jnp.concatenate([x1 * c - x2 * s, x2 * c + x1 * s], axis=-1).astype(x.dtype)


def partial_rope(x, cos, sin):
    r = 2 * cos.shape[1]
    return jnp.concatenate([apply_rope(x[..., :r], cos, sin), x[..., r:]], axis=-1)


def sweep_query_blocks(fn, *q_arrays):
    b, s = q_arrays[0].shape[:2]
    nb = s // Q_BLOCK
    def split(a):
        return jnp.moveaxis(a.reshape((b, nb, Q_BLOCK) + a.shape[2:]), 1, 0)
    out = lax.map(lambda args: fn(args[0], *args[1:]),
                  (jnp.arange(nb),) + tuple(split(a) for a in q_arrays))
    out = jnp.moveaxis(out, 0, 1)
    return out.reshape((b, s) + out.shape[3:])


def chunk_causal_mask(block_idx, seq):
    qpos = block_idx * Q_BLOCK + jnp.arange(Q_BLOCK)
    kpos = jnp.arange(seq)
    return (kpos[None, :] // CHUNK) <= (qpos[:, None] // CHUNK)


def diff_attention(q1, q2, k1, k2, v, lam, subln, lambda_init):
    seq = k1.shape[1]
    scale = DIFF_QK_DIM ** -0.5
    def block(bi, q1b, q2b):
        allowed = chunk_causal_mask(bi, seq)
        def probs(qb, k):
            sc = jnp.einsum('bqhd,bkhd->bhqk', qb, k).astype(jnp.float32) * scale
            return jax.nn.softmax(jnp.where(allowed, sc, -jnp.inf), axis=-1)
        p = probs(q1b, k1) - lam * probs(q2b, k2)
        return jnp.einsum('bhqk,bkhd->bqhd', p.astype(v.dtype), v)
    o = sweep_query_blocks(block, q1, q2)
    return rms_norm(o, subln) * (1.0 - lambda_init)


def mla_attention(q, k_nope, k_rope, v):
    seq = k_nope.shape[1]
    scale = (MLA_NOPE_DIM + MLA_ROPE_DIM) ** -0.5
    def block(bi, qb):
        allowed = chunk_causal_mask(bi, seq)
        sc = (jnp.einsum('bqhd,bkhd->bhqk', qb[..., :MLA_NOPE_DIM], k_nope)
              + jnp.einsum('bqhd,bkd->bhqk', qb[..., MLA_NOPE_DIM:], k_rope))
        sc = sc.astype(jnp.float32) * scale
        p = jax.nn.softmax(jnp.where(allowed, sc, -jnp.inf), axis=-1)
        return jnp.einsum('bhqk,bkhd->bqhd', p.astype(v.dtype), v)
    return sweep_query_blocks(block, q)


def stick_breaking_attention(q, k, v):
    seq = k.shape[1]
    scale = SB_DIM ** -0.5
    kpos = jnp.arange(seq)
    def block(bi, qb):
        qpos = bi * Q_BLOCK + jnp.arange(Q_BLOCK)
        causal = kpos[None, :] < qpos[:, None]
        z = jnp.einsum('bqhd,bkhd->bhqk', qb, k).astype(jnp.float32) * scale
        neg_log_fail = jnp.where(causal, jax.nn.softplus(z), 0.0)
        after = lax.cumsum(neg_log_fail, axis=3, reverse=True) - neg_log_fail
        a = jnp.where(causal, jnp.exp(jax.nn.log_sigmoid(z) - after), 0.0)
        return jnp.einsum('bhqk,bkhd->bqhd', a.astype(v.dtype), v)
    return sweep_query_blocks(block, q)


def hybrid_mixer(h, layer_idx, w_in, lam_q1, lam_k1, lam_q2, lam_k2, diff_subln,
                 mla_q_norm, mla_w_uq, mla_kv_norm, mla_w_ukv, w_out,
                 cos_d, sin_d, cos_m, sin_m):
    b, s, _ = h.shape
    proj = h @ w_in
    pa = proj[..., :DIFF_COLS]
    pb = proj[..., DIFF_COLS:DIFF_COLS + MLA_COLS]
    pc = proj[..., DIFF_COLS + MLA_COLS:]

    qk_w = DIFF_HEADS * 2 * DIFF_QK_DIM
    qa = partial_rope(pa[..., :qk_w].reshape(b, s, DIFF_HEADS, 2, DIFF_QK_DIM), cos_d, sin_d)
    ka = partial_rope(pa[..., qk_w:2 * qk_w].reshape(b, s, DIFF_HEADS, 2, DIFF_QK_DIM), cos_d, sin_d)
    va = pa[..., 2 * qk_w:].reshape(b, s, DIFF_HEADS, DIFF_V_DIM)
    lambda_init = 0.8 - 0.6 * math.exp(-0.3 * layer_idx)
    lam = (jnp.exp(jnp.sum(lam_q1.astype(jnp.float32) * lam_k1.astype(jnp.float32)))
           - jnp.exp(jnp.sum(lam_q2.astype(jnp.float32) * lam_k2.astype(jnp.float32)))
           + lambda_init)
    out_a = diff_attention(qa[..., 0, :], qa[..., 1, :], ka[..., 0, :], ka[..., 1, :],
                           va, lam, diff_subln, lambda_init)

    c_q = rms_norm(pb[..., :MLA_Q_LORA], mla_q_norm)
    c_kv = rms_norm(pb[..., MLA_Q_LORA:MLA_Q_LORA + MLA_KV_LORA], mla_kv_norm)
    k_rope = apply_rope(pb[..., MLA_Q_LORA + MLA_KV_LORA:], cos_m, sin_m)
    qb = (c_q @ mla_w_uq).reshape(b, s, MLA_HEADS, MLA_NOPE_DIM + MLA_ROPE_DIM)
    qb = jnp.concatenate([qb[..., :MLA_NOPE_DIM],
                          apply_rope(qb[..., MLA_NOPE_DIM:], cos_m, sin_m)], axis=-1)
    kv = (c_kv @ mla_w_ukv).reshape(b, s, MLA_HEADS, MLA_NOPE_DIM + MLA_V_DIM)
    out_b = mla_attention(qb, kv[..., :MLA_NOPE_DIM], k_rope, kv[..., MLA_NOPE_DIM:])

    sb_w = SB_HEADS * SB_DIM
    qc = pc[..., :sb_w].reshape(b, s, SB_HEADS, SB_DIM)
    kc = pc[..., sb_w:2 * sb_w].reshape(b, s, SB_HEADS, SB_DIM)
    vc = pc[..., 2 * sb_w:].reshape(b, s, SB_HEADS, SB_DIM)
    out_c = stick_breaking_attention(qc, kc, vc)

    merged = jnp.concatenate([out_a.reshape(b, s, -1), out_b.reshape(b, s, -1),
                              out_c.reshape(b, s, -1)], axis=-1)
    return merged @ w_out


def setup_inputs(seed: int = 0):
    key = jax.random.key(seed)
    ks = jax.random.split(key, 24)
    f32 = jnp.float32
    L = DEPTH
    def nrm(k, shape, scale):
        return jax.random.normal(k, shape, f32) * scale
    def gain(k, shape):
        return 1.0 + 0.02 * jax.random.normal(k, shape, f32)
    return {
        'x': nrm(ks[0], (BATCH, SEQ, D_MODEL), 1.0),
        'ffn1_norm': gain(ks[1], (L, D_MODEL)),
        'ffn1_w_gate': nrm(ks[2], (L, D_MODEL, D_FF), D_MODEL ** -0.5),
        'ffn1_w_up': nrm(ks[3], (L, D_MODEL, D_FF), D_MODEL ** -0.5),
        'ffn1_w_down': nrm(ks[4], (L, D_FF, D_MODEL), D_FF ** -0.5),
        'mix_norm': gain(ks[5], (L, D_MODEL)),
        'w_in': nrm(ks[6], (L, D_MODEL, IN_COLS), D_MODEL ** -0.5),
        'diff_lambda_q1': nrm(ks[7], (L, DIFF_QK_DIM), 0.1),
        'diff_lambda_k1': nrm(ks[8], (L, DIFF_QK_DIM), 0.1),
        'diff_lambda_q2': nrm(ks[9], (L, DIFF_QK_DIM), 0.1),
        'diff_lambda_k2': nrm(ks[10], (L, DIFF_QK_DIM), 0.1),
        'diff_subln': gain(ks[11], (L, DIFF_V_DIM)),
        'mla_q_norm': gain(ks[12], (L, MLA_Q_LORA)),
        'mla_w_uq': nrm(ks[13], (L, MLA_Q_LORA, MLA_UQ_COLS), MLA_Q_LORA ** -0.5),
        'mla_kv_norm': gain(ks[14], (L, MLA_KV_LORA)),
        'mla_w_ukv': nrm(ks[15], (L, MLA_KV_LORA, MLA_UKV_COLS), MLA_KV_LORA ** -0.5),
        'w_out': nrm(ks[16], (L, D_MIX, D_MODEL), D_MIX ** -0.5),
        'ffn2_norm': gain(ks[17], (L, D_MODEL)),
        'ffn2_w_gate': nrm(ks[18], (L, D_MODEL, D_FF), D_MODEL ** -0.5),
        'ffn2_w_up': nrm(ks[19], (L, D_MODEL, D_FF), D_MODEL ** -0.5),
        'ffn2_w_down': nrm(ks[20], (L, D_FF, D_MODEL), D_FF ** -0.5),
        'final_norm': gain(ks[21], (D_MODEL,)),
    }


def reference(x, ffn1_norm, ffn1_w_gate, ffn1_w_up, ffn1_w_down, mix_norm, w_in,
              diff_lambda_q1, diff_lambda_k1, diff_lambda_q2, diff_lambda_k2, diff_subln,
              mla_q_norm, mla_w_uq, mla_kv_norm, mla_w_ukv, w_out,
              ffn2_norm, ffn2_w_gate, ffn2_w_up, ffn2_w_down, final_norm):
    seq = x.shape[1]
    cos_d, sin_d = rope_tables(DIFF_ROT_DIM, seq)
    cos_m, sin_m = rope_tables(MLA_ROPE_DIM, seq)
    h = x
    for i in range(DEPTH):
        h = h + 0.5 * swiglu(rms_norm(h, ffn1_norm[i]), ffn1_w_gate[i], ffn1_w_up[i], ffn1_w_down[i])
        h = h + hybrid_mixer(rms_norm(h, mix_norm[i]), i, w_in[i],
                             diff_lambda_q1[i], diff_lambda_k1[i], diff_lambda_q2[i], diff_lambda_k2[i],
                             diff_subln[i], mla_q_norm[i], mla_w_uq[i], mla_kv_norm[i], mla_w_ukv[i],
                             w_out[i], cos_d, sin_d, cos_m, sin_m)
        h = h + 0.5 * swiglu(rms_norm(h, ffn2_norm[i]), ffn2_w_gate[i], ffn2_w_up[i], ffn2_w_down[i])
    return rms_norm(h, final_norm)
```

```cpp
#include <hip/hip_runtime.h>
#include <hip/hip_cooperative_groups.h>
#include <hip/hip_bf16.h>
#include <cstdio>
#include <cstdint>
namespace cg = cooperative_groups;
#define SWZ_XOR(v, o) __builtin_bit_cast(float, __builtin_amdgcn_ds_swizzle(__builtin_bit_cast(int, (float)(v)), (((o) << 10) | 0x1F)))
__device__ __forceinline__ float x32_sum(float v) { auto rr = __builtin_amdgcn_permlane32_swap(__builtin_bit_cast(unsigned, v), __builtin_bit_cast(unsigned, v), false, false); return __builtin_bit_cast(float, (unsigned)rr[0]) + __builtin_bit_cast(float, (unsigned)rr[1]); }
__device__ __forceinline__ float x32_max(float v) { auto rr = __builtin_amdgcn_permlane32_swap(__builtin_bit_cast(unsigned, v), __builtin_bit_cast(unsigned, v), false, false); return fmaxf(__builtin_bit_cast(float, (unsigned)rr[0]), __builtin_bit_cast(float, (unsigned)rr[1])); }
__device__ __forceinline__ float x32_other(float v, int hi) { auto rr = __builtin_amdgcn_permlane32_swap(__builtin_bit_cast(unsigned, v), __builtin_bit_cast(unsigned, v), false, false); return hi ? __builtin_bit_cast(float, (unsigned)rr[0]) : __builtin_bit_cast(float, (unsigned)rr[1]); }
__device__ __forceinline__ float wave_sum(float v) { v += SWZ_XOR(v, 1); v += SWZ_XOR(v, 2); v += SWZ_XOR(v, 4); v += SWZ_XOR(v, 8); v += SWZ_XOR(v, 16); return x32_sum(v); }
namespace pg8 {
#define PG8_LAS __attribute__((address_space(3)))
typedef unsigned short bf16_t;
typedef short bf16x8 __attribute__((ext_vector_type(8)));
typedef float f32x4 __attribute__((ext_vector_type(4)));
typedef unsigned u32x4 __attribute__((ext_vector_type(4)));
constexpr int BM = 256, BK = 64, HALF = 128, HTB = HALF * BK * 2  , STAGE_BYTES = 8 * HTB, NXCD = 8, WGM = 8;

__host__ __device__ __forceinline__ int lds_byte(int r, int c) { const int st = (r >> 4) * 2 + (c >> 5), rr = r & 15, cc = c & 31, ob = rr * 64 + cc * 2; return st * 1024 + (ob ^ (((ob >> 9) & 1) << 5)); }
__host__ __device__ __forceinline__ void stage_rc(int b, int& R, int& C) { const int st = b / 1024, sb = b % 1024, swz = sb ^ (((sb >> 9) & 1) << 5); R = (st >> 1) * 16 + swz / 64; C = (st & 1) * 32 + (swz % 64) / 2; }
__host__ __device__ __forceinline__ int perm32(int rho) { const int n = rho >> 4, i = rho & 15; return 8 * (i >> 2) + 4 * n + (i & 3); }

struct Unit { int pm, pn, ord; };
struct Gemm { const bf16_t* A; const bf16_t* Bt; int M, N, K, lda, ldb; };

struct StaticOrder {
    int nM, nN, nwg, G, c;
    __host__ __device__ void init(int M, int N, int G_, int c_) { nM = M / BM; nN = N / BM; nwg = nM * nN; G = G_; c = c_; }
    __host__ __device__ bool next(int i, Unit& u) const {
        const long L = (long)i * G + c; if (L >= nwg) return false;
        int wgid = (int)L; { const int q = nwg / NXCD, r = nwg % NXCD, xcd = wgid % NXCD, off = wgid / NXCD; wgid = (xcd < r ? xcd * (q + 1) : r * (q + 1) + (xcd - r) * q) + off; }
        const int nig = WGM * nN, gid = wgid / nig, fm = gid * WGM, gsz = (nM - fm) < WGM ? (nM - fm) : WGM;
        u.pm = fm + ((wgid % nig) % gsz); u.pn = (wgid % nig) / gsz; u.ord = i; return true;
    }
    __device__ __forceinline__ void a_ready(const Unit&) const {}
    __device__ __forceinline__ void done(const Unit&) const {}
};

typedef float f32x2 __attribute__((ext_vector_type(2)));
typedef __bf16 bf16x2_t __attribute__((ext_vector_type(2)));
typedef unsigned u32x2 __attribute__((ext_vector_type(2)));
__device__ __forceinline__ unsigned cvt_pk_bf16(float lo, float hi) { f32x2 v = {lo, hi}; bf16x2_t b = __builtin_convertvector(v, bf16x2_t); return __builtin_bit_cast(unsigned, b); }
constexpr float RMS_EPS = 1e-6f;
constexpr float LOG2E = 1.4426950408889634f;
__device__ __forceinline__ float sum16(const float* p) { const f32x4 a = *(const f32x4*)p, b = *(const f32x4*)(p + 4), c = *(const f32x4*)(p + 8), d = *(const f32x4*)(p + 12);
    return ((a[0] + a[1]) + (a[2] + a[3])) + ((b[0] + b[1]) + (b[2] + b[3])) + ((c[0] + c[1]) + (c[2] + c[3])) + ((d[0] + d[1]) + (d[2] + d[3])); }
__device__ __forceinline__ float sum4(const float* p) { const f32x4 a = *(const f32x4*)p; return (a[0] + a[1]) + (a[2] + a[3]); }
__device__ __forceinline__ float dot4(const f32x4 a) { return (a[0] * a[0] + a[1] * a[1]) + (a[2] * a[2] + a[3] * a[3]); }
__device__ __forceinline__ void rope4(f32x4& x1, f32x4& x2, const f32x4 c, const f32x4 s) { const f32x4 a = x1 * c - x2 * s, b = x2 * c + x1 * s; x1 = a; x2 = b; }

struct EpiUp {
    static constexpr bool PERM = true, AFTER_DRAIN = false;
    bf16_t* H; const PG8_LAS float* rst; int ldh;
    __device__ __forceinline__ void operator()(const f32x4 (&acc)[2][2][4][2], const Unit& u, int wr, int wc, int fr, int fq) const {
        const int rl0 = wr * 64 + fr, row0 = u.pm * BM + rl0, col0 = u.pn * HALF + wc * 32 + 8 * fq;
        const PG8_LAS float* rt = rst + u.ord * BM + rl0;
#pragma unroll
        for (int ai = 0; ai < 2; ++ai)
#pragma unroll
            for (int m = 0; m < 4; ++m) { const int row = row0 + ai * HALF + m * 16;
                const float rs = rt[ai * HALF + m * 16];
                float hv[8];
#pragma unroll
                for (int n = 0; n < 2; ++n)
#pragma unroll
                    for (int e = 0; e < 4; ++e) { const float g = acc[ai][0][m][n][e] * rs, up = acc[ai][1][m][n][e] * rs;
                        const float sg = g * __builtin_amdgcn_rcpf(1.0f + __builtin_amdgcn_exp2f(-g * LOG2E)); hv[n * 4 + e] = sg * up; }
                u32x4 w; w.x = cvt_pk_bf16(hv[0], hv[1]); w.y = cvt_pk_bf16(hv[2], hv[3]); w.z = cvt_pk_bf16(hv[4], hv[5]); w.w = cvt_pk_bf16(hv[6], hv[7]);
                *(u32x4*)(H + (size_t)row * ldh + col0) = w; }
    }
};
__device__ __forceinline__ float bf_lo(unsigned w) { return __builtin_bit_cast(float, w << 16); }
__device__ __forceinline__ float bf_hi(unsigned w) { return __builtin_bit_cast(float, w & 0xffff0000u); }
struct EpiRes {
    static constexpr bool PERM = true, AFTER_DRAIN = false;
    bf16_t* xb; float* part; float s;
    __device__ __forceinline__ void operator()(const f32x4 (&acc)[2][2][4][2], const Unit& u, int wr, int wc, int fr, int fq) const {
        const int row0 = u.pm * BM + wr * 64 + fr, col0 = u.pn * BM + wc * 32 + 8 * fq;
#pragma unroll
        for (int ai = 0; ai < 2; ++ai) {
            u32x4 pre[4][2];
#pragma unroll
            for (int m = 0; m < 4; ++m) { const size_t off = (size_t)(row0 + ai * HALF + m * 16) * 1024 + col0;
#pragma unroll
                for (int bj = 0; bj < 2; ++bj) pre[m][bj] = *(const u32x4*)(xb + off + bj * HALF); }
#pragma unroll
            for (int m = 0; m < 4; ++m) { const int row = row0 + ai * HALF + m * 16; const size_t off = (size_t)row * 1024 + col0; float ss = 0.f;
#pragma unroll
                for (int bj = 0; bj < 2; ++bj) { const u32x4 b = pre[m][bj];
                    const f32x4 v0 = (f32x4){bf_lo(b.x), bf_hi(b.x), bf_lo(b.y), bf_hi(b.y)} + acc[ai][bj][m][0] * s;
                    const f32x4 v1 = (f32x4){bf_lo(b.z), bf_hi(b.z), bf_lo(b.w), bf_hi(b.w)} + acc[ai][bj][m][1] * s;
                    u32x4 w; w.x = cvt_pk_bf16(v0[0], v0[1]); w.y = cvt_pk_bf16(v0[2], v0[3]); w.z = cvt_pk_bf16(v1[0], v1[1]); w.w = cvt_pk_bf16(v1[2], v1[3]);
                    *(u32x4*)(xb + off + bj * HALF) = w; ss += dot4(v0) + dot4(v1); }
                ss += SWZ_XOR(ss, 16); ss = x32_sum(ss);
                if (fq == 0) part[(size_t)row * 16 + u.pn * 4 + wc] = ss; }
            asm volatile("" ::: "memory"); }
    }
};
struct EpiIn {
    static constexpr bool PERM = true, AFTER_DRAIN = false;
    bf16_t* P; const PG8_LAS float* rst; float* partq; float* partkv; const float* cosd; const float* sind; const float* cosm; const float* sinm; int ldp; float qscale;
    __device__ __forceinline__ void operator()(const f32x4 (&acc)[2][2][4][2], const Unit& u, int wr, int wc, int fr, int fq) const {
        const int tile = u.pn; const int rl0 = wr * 64 + fr, row0 = u.pm * BM + rl0, col0 = tile * BM + wc * 32 + 8 * fq;
        const PG8_LAS float* rt = rst + u.ord * BM + rl0;
        const float cs = (tile < 2 || tile == 8) ? qscale : 1.0f;
        const bool ropeD = (tile < 4) && ((wc & 1) == 0) && (fq < 2);
        const bool ropeM = (tile == 7) && (wc == 0);
        const float* ct = ropeD ? cosd : cosm; const float* sn = ropeD ? sind : sinm; const int sh = ropeD ? 3 : 4;
#pragma unroll
        for (int ai = 0; ai < 2; ++ai) {
            f32x4 rc[4], rsn[4];
            if (ropeD || ropeM) {
#pragma unroll
                for (int m = 0; m < 4; ++m) { const int pos = (row0 + ai * HALF + m * 16) & 4095; rc[m] = *(const f32x4*)(ct + (pos << sh) + 4 * fq); rsn[m] = *(const f32x4*)(sn + (pos << sh) + 4 * fq); } }
#pragma unroll
            for (int m = 0; m < 4; ++m) { const int row = row0 + ai * HALF + m * 16;
                const float rs = cs * rt[ai * HALF + m * 16];
                f32x4 v[2][2];
#pragma unroll
                for (int bj = 0; bj < 2; ++bj)
#pragma unroll
                    for (int n = 0; n < 2; ++n) v[bj][n] = acc[ai][bj][m][n] * rs;
                if (ropeD) { rope4(v[0][0], v[0][1], rc[m], rsn[m]); rope4(v[1][0], v[1][1], rc[m], rsn[m]); }
                if (ropeM) { rope4(v[1][0], v[1][1], rc[m], rsn[m]); }
                if (tile == 6) { float ss = (dot4(v[0][0]) + dot4(v[0][1])) + (dot4(v[1][0]) + dot4(v[1][1])); ss += SWZ_XOR(ss, 16); ss = x32_sum(ss); if (fq == 0) partq[(size_t)row * 4 + wc] = ss; }
                if (tile == 7) { float ss = dot4(v[0][0]) + dot4(v[0][1]); ss += SWZ_XOR(ss, 16); ss = x32_sum(ss); if (fq == 0) partkv[(size_t)row * 4 + wc] = ss; }
#pragma unroll
                for (int bj = 0; bj < 2; ++bj) { u32x4 w; w.x = cvt_pk_bf16(v[bj][0][0], v[bj][0][1]); w.y = cvt_pk_bf16(v[bj][0][2], v[bj][0][3]); w.z = cvt_pk_bf16(v[bj][1][0], v[bj][1][1]); w.w = cvt_pk_bf16(v[bj][1][2], v[bj][1][3]);
                    *(u32x4*)(P + (size_t)row * ldp + col0 + bj * HALF) = w; }
                asm volatile("" ::: "memory"); } }
    }
};
template <bool ROPE> struct EpiMla {
    static constexpr bool PERM = true, AFTER_DRAIN = false;
    bf16_t* O; const PG8_LAS float* rst; const float* cosm; const float* sinm; int ldo;
    __device__ __forceinline__ void operator()(const f32x4 (&acc)[2][2][4][2], const Unit& u, int wr, int wc, int fr, int fq) const {
        const int rl0 = wr * 64 + fr, row0 = u.pm * BM + rl0, col0 = u.pn * BM + wc * 32 + 8 * fq;
        const PG8_LAS float* rt = rst + u.ord * BM + rl0;
#pragma unroll
        for (int ai = 0; ai < 2; ++ai)
#pragma unroll
            for (int m = 0; m < 4; ++m) { const int row = row0 + ai * HALF + m * 16; const int pos = row & 4095;
                const float rs = rt[ai * HALF + m * 16];
                f32x4 v[2][2];
#pragma unroll
                for (int bj = 0; bj < 2; ++bj)
#pragma unroll
                    for (int n = 0; n < 2; ++n) v[bj][n] = acc[ai][bj][m][n] * rs;
                if (ROPE && wc == 2) { const f32x4 c = *(const f32x4*)(cosm + pos * 16 + 4 * fq), s = *(const f32x4*)(sinm + pos * 16 + 4 * fq); rope4(v[0][0], v[0][1], c, s); rope4(v[1][0], v[1][1], c, s); }
#pragma unroll
                for (int bj = 0; bj < 2; ++bj) { u32x4 w; w.x = cvt_pk_bf16(v[bj][0][0], v[bj][0][1]); w.y = cvt_pk_bf16(v[bj][0][2], v[bj][0][3]); w.z = cvt_pk_bf16(v[bj][1][0], v[bj][1][1]); w.w = cvt_pk_bf16(v[bj][1][2], v[bj][1][3]);
                    *(u32x4*)(O + (size_t)row * ldo + col0 + bj * HALF) = w; }
                asm volatile("" ::: "memory"); }
    }
};

template <int NP, class Sched>
__device__ __forceinline__ void fill_rowscale(PG8_LAS float* tab, const Sched& S, const float* parts, float inv_n, float scale, int tid) {
    Unit u; int nu = 0; while (S.next(nu, u)) ++nu;
    constexpr bool WIDE = (NP == 16);
    const int r0 = WIDE ? (tid >> 2) : (tid & 255), q = WIDE ? (tid & 3) : 0;
    const bool on = WIDE || tid < 256;
    f32x4 c0 = {0.f, 0.f, 0.f, 0.f}, c1 = c0, n0 = c0, n1 = c0;
    if (nu > 0 && on) { S.next(0, u); const float* p = parts + ((size_t)u.pm * BM + r0) * NP + q * 4; c0 = *(const f32x4*)p; if (WIDE) c1 = *(const f32x4*)(p + 128 * NP); }
    for (int i = 0; i < nu; ++i) {
        if (i + 1 < nu && on) { S.next(i + 1, u); const float* p = parts + ((size_t)u.pm * BM + r0) * NP + q * 4; n0 = *(const f32x4*)p; if (WIDE) n1 = *(const f32x4*)(p + 128 * NP); }
        float s0 = (c0[0] + c0[1]) + (c0[2] + c0[3]), s1 = (c1[0] + c1[1]) + (c1[2] + c1[3]);
        if (WIDE) { s0 += SWZ_XOR(s0, 1); s0 += SWZ_XOR(s0, 2); s1 += SWZ_XOR(s1, 1); s1 += SWZ_XOR(s1, 2); }
        if (on && q == 0) { tab[i * BM + r0] = scale / sqrtf(s0 * inv_n + RMS_EPS); if (WIDE) tab[i * BM + 128 + r0] = scale / sqrtf(s1 * inv_n + RMS_EPS); }
        c0 = n0; c1 = n1;
    }
    asm volatile("s_waitcnt lgkmcnt(0)" ::: "memory"); __builtin_amdgcn_s_barrier(); asm volatile("" ::: "memory");
}
template <class Epi, class Sched, bool ALIGN_EPI = false, bool SP2 = false>
__device__ __forceinline__ void gemm_phase(PG8_LAS unsigned char* lds, const Gemm g, const Sched& S, const Epi& E, int wave_in  ) {
    unsigned m_ = ~0u; asm volatile("" : "+s"(m_), "+s"(wave_in)); const int tid_ = wave_in * 64 + (int)__builtin_amdgcn_mbcnt_hi(m_, __builtin_amdgcn_mbcnt_lo(m_, 0u));
    const int tid = tid_, wid = __builtin_amdgcn_readfirstlane(tid >> 6), lane = tid & 63, wr = wid >> 2, wc = wid & 3, fr = lane & 15, fq = lane >> 4;
    const int K = g.K, nt = K / BK;
    unsigned voffA[2], voffB[2];
#pragma unroll
    for (int i = 0; i < 2; ++i) { int R, C; stage_rc(tid * 16 + i * 8192, R, C); const int Rb = Epi::PERM ? ((R & ~31) + perm32(R & 31)) : R;
        voffA[i] = (unsigned)(R * g.lda + C) * 2u; voffB[i] = (unsigned)(Rb * g.ldb + C) * 2u; }
    const size_t kstep = (size_t)(BK * 2);
    const size_t hstepA = (size_t)HALF * g.lda * 2, hstepB = (size_t)HALF * g.ldb * 2;
    const size_t tstepA = 2 * hstepA, tstepB = 2 * hstepB;
    const unsigned ldsw = (unsigned)wid * 1024u;
    const int aoff = lds_byte(wr * 64 + fr, fq * 8), boff = lds_byte(wc * 32 + fr, fq * 8);
#define PG8_SA(b, h) (((b) * 2 + (h)) * HTB)
#define PG8_SB(b, h) ((4 + (b) * 2 + (h)) * HTB)
#define PG8_STAGE(bufoff, gbase, voff) do { _Pragma("unroll") for (int _i = 0; _i < 2; ++_i) \
        __builtin_amdgcn_global_load_lds((const unsigned*)((const char*)(gbase) + (voff)[_i]), (PG8_LAS unsigned*)(lds + (bufoff) + ldsw + _i * 8192), 16, 0, 0); } while (0)
#define PG8_LDA(dst, b, h) do { _Pragma("unroll") for (int m = 0; m < 4; ++m) _Pragma("unroll") for (int k = 0; k < 2; ++k) dst[m][k] = *(const PG8_LAS bf16x8*)(lds + PG8_SA(b, h) + aoff + m * 2048 + k * 1024); } while (0)
#define PG8_LDB(dst, b, h) do { _Pragma("unroll") for (int n = 0; n < 2; ++n) _Pragma("unroll") for (int k = 0; k < 2; ++k) dst[n][k] = *(const PG8_LAS bf16x8*)(lds + PG8_SB(b, h) + boff + n * 2048 + k * 1024); } while (0)
#define PG8_MMA(ai, bj, At, Bt) do { __builtin_amdgcn_s_setprio(1); _Pragma("unroll") for (int m = 0; m < 4; ++m) _Pragma("unroll") for (int n = 0; n < 2; ++n) _Pragma("unroll") for (int k = 0; k < 2; ++k) \
        acc[ai][bj][m][n] = __builtin_amdgcn_mfma_f32_16x16x32_bf16(Bt[n][k], At[m][k], acc[ai][bj][m][n], 0, 0, 0); __builtin_amdgcn_s_setprio(0); } while (0)
#define PG8_WAIT_V(n) asm volatile("s_waitcnt vmcnt(" #n ")" ::: "memory")
#define PG8_WAIT_L(n) asm volatile("s_waitcnt lgkmcnt(" #n ")" ::: "memory")
#define PG8_BAR __builtin_amdgcn_s_barrier()
#define PG8_SCHED __builtin_amdgcn_sched_barrier(0)
    Unit cur, nxt; int ui = 0;
    if (!S.next(0, cur)) return;
    f32x4 acc[2][2][4][2];
#pragma unroll
    for (int a = 0; a < 2; ++a)
#pragma unroll
        for (int b = 0; b < 2; ++b)
#pragma unroll
            for (int m = 0; m < 4; ++m)
#pragma unroll
                for (int n = 0; n < 2; ++n) acc[a][b][m][n] = (f32x4){0.f, 0.f, 0.f, 0.f};
    bf16x8 At[4][2], B0[2][2], B1[2][2];
    const char* cA = (const char*)g.A + (size_t)cur.pm * tstepA; const char* cB = (const char*)g.Bt + (size_t)cur.pn * tstepB;
    S.a_ready(cur);
    if constexpr (SP2) {
        PG8_STAGE(PG8_SB(0, 0), cB, voffB); PG8_STAGE(PG8_SB(0, 1), cB + hstepB, voffB); PG8_STAGE(PG8_SA(0, 0), cA, voffA); PG8_STAGE(PG8_SA(0, 1), cA + hstepA, voffA);
        if (wr == 1) PG8_BAR;
        PG8_WAIT_V(2); PG8_BAR;
        PG8_STAGE(PG8_SB(1, 0), cB + kstep, voffB); PG8_STAGE(PG8_SA(1, 0), cA + kstep, voffA); PG8_STAGE(PG8_SB(1, 1), cB + hstepB + kstep, voffB);
        PG8_WAIT_V(6); PG8_BAR;
    } else {
        PG8_STAGE(PG8_SB(0, 0), cB, voffB); PG8_STAGE(PG8_SA(0, 0), cA, voffA); PG8_STAGE(PG8_SB(0, 1), cB + hstepB, voffB); PG8_STAGE(PG8_SA(0, 1), cA + hstepA, voffA);
        if (wr == 1) PG8_BAR;
        PG8_WAIT_V(4); PG8_BAR;
        PG8_STAGE(PG8_SB(1, 0), cB + kstep, voffB); PG8_STAGE(PG8_SA(1, 0), cA + kstep, voffA); PG8_STAGE(PG8_SB(1, 1), cB + hstepB + kstep, voffB);
        PG8_WAIT_V(6); PG8_BAR;
    }
    for (;;) {
        const bool has_next = S.next(ui + 1, nxt);
        const char* nA = has_next ? (const char*)g.A + (size_t)nxt.pm * tstepA : cA; const char* nB = has_next ? (const char*)g.Bt + (size_t)nxt.pn * tstepB : cB;
        for (int t = 0; t < nt; t += 2) {
            const bool last = (t == nt - 2);
            const char* a1 = cA + (size_t)(t + 1) * kstep;
            const char* a2 = last ? nA : cA + (size_t)(t + 2) * kstep; const char* b2 = last ? nB : cB + (size_t)(t + 2) * kstep;
            const char* a3 = a2 + kstep; const char* b3 = b2 + kstep;
            if (last && has_next) S.a_ready(nxt);
            if constexpr (SP2) {
            PG8_LDB(B0, 0, 0); PG8_LDB(B1, 0, 1); PG8_SCHED; PG8_LDA(At, 0, 0); PG8_STAGE(PG8_SA(1, 1), a1 + hstepA, voffA);
            PG8_WAIT_V(8); PG8_WAIT_L(0); PG8_BAR; PG8_MMA(0, 0, At, B0); PG8_MMA(0, 1, At, B1); PG8_BAR; PG8_SCHED;
            PG8_LDA(At, 0, 1); PG8_STAGE(PG8_SB(0, 0), b2, voffB); PG8_STAGE(PG8_SB(0, 1), b2 + hstepB, voffB); PG8_STAGE(PG8_SA(0, 0), a2, voffA);
            PG8_WAIT_V(8); PG8_WAIT_L(0); PG8_BAR; PG8_MMA(1, 0, At, B0); PG8_MMA(1, 1, At, B1); PG8_BAR; PG8_SCHED;
            PG8_LDB(B0, 1, 0); PG8_LDB(B1, 1, 1); PG8_SCHED; PG8_LDA(At, 1, 0); PG8_STAGE(PG8_SA(0, 1), a2 + hstepA, voffA);
            PG8_WAIT_V(8); PG8_WAIT_L(0); PG8_BAR; PG8_MMA(0, 0, At, B0); PG8_MMA(0, 1, At, B1); PG8_BAR; PG8_SCHED;
            PG8_LDA(At, 1, 1); PG8_STAGE(PG8_SB(1, 0), b3, voffB); PG8_STAGE(PG8_SB(1, 1), b3 + hstepB, voffB); PG8_STAGE(PG8_SA(1, 0), a3, voffA);
            PG8_WAIT_V(8); PG8_WAIT_L(0); PG8_BAR; PG8_MMA(1, 0, At, B0); PG8_MMA(1, 1, At, B1); PG8_BAR; PG8_SCHED;
            } else {
            PG8_LDB(B0, 0, 0); PG8_SCHED; PG8_LDA(At, 0, 0); PG8_STAGE(PG8_SA(1, 1), a1 + hstepA, voffA);
            PG8_WAIT_L(8); PG8_BAR; PG8_WAIT_L(0); PG8_MMA(0, 0, At, B0); PG8_BAR; PG8_SCHED;
            PG8_LDB(B1, 0, 1); PG8_STAGE(PG8_SB(0, 0), b2, voffB);
            PG8_BAR; PG8_WAIT_L(0); PG8_MMA(0, 1, At, B1); PG8_BAR;
            PG8_LDA(At, 0, 1); PG8_STAGE(PG8_SA(0, 0), a2, voffA);
            PG8_BAR; PG8_WAIT_L(0); PG8_MMA(1, 0, At, B0); PG8_BAR; PG8_SCHED;
            PG8_STAGE(PG8_SB(0, 1), b2 + hstepB, voffB);
            PG8_WAIT_V(6); PG8_BAR; PG8_MMA(1, 1, At, B1); PG8_BAR;
            PG8_LDB(B0, 1, 0); PG8_SCHED; PG8_LDA(At, 1, 0); PG8_STAGE(PG8_SA(0, 1), a2 + hstepA, voffA);
            PG8_WAIT_L(8); PG8_BAR; PG8_WAIT_L(0); PG8_MMA(0, 0, At, B0); PG8_BAR; PG8_SCHED;
            PG8_LDB(B1, 1, 1); PG8_STAGE(PG8_SB(1, 0), b3, voffB);
            PG8_BAR; PG8_WAIT_L(0); PG8_MMA(0, 1, At, B1); PG8_BAR;
            PG8_LDA(At, 1, 1); PG8_STAGE(PG8_SA(1, 0), a3, voffA);
            PG8_BAR; PG8_WAIT_L(0); PG8_MMA(1, 0, At, B0); PG8_BAR; PG8_SCHED;
            PG8_STAGE(PG8_SB(1, 1), b3 + hstepB, voffB);
            PG8_WAIT_V(6); PG8_BAR; PG8_MMA(1, 1, At, B1); PG8_BAR;
            }
        }
        if constexpr (ALIGN_EPI) { if (wr == 0) PG8_BAR; }
        if constexpr (!Epi::AFTER_DRAIN) { unsigned m2_ = ~0u; asm volatile("" : "+s"(m2_)); const int ln_ = (int)__builtin_amdgcn_mbcnt_hi(m2_, __builtin_amdgcn_mbcnt_lo(m2_, 0u)); E(acc, cur, wr, wc, ln_ & 15, ln_ >> 4); S.done(cur); }
        if (!has_next) break;
#pragma unroll
        for (int a = 0; a < 2; ++a)
#pragma unroll
            for (int b = 0; b < 2; ++b)
#pragma unroll
                for (int m = 0; m < 4; ++m)
#pragma unroll
                    for (int n = 0; n < 2; ++n) acc[a][b][m][n] = (f32x4){0.f, 0.f, 0.f, 0.f};
        cur = nxt; cA = nA; cB = nB; ++ui;
        if constexpr (ALIGN_EPI) { if (wr == 1) PG8_BAR; }
    }
    PG8_WAIT_V(0);
    if constexpr (!ALIGN_EPI) { if (wr == 0) PG8_BAR; }
    PG8_BAR;
    if constexpr (Epi::AFTER_DRAIN) { E.fused(acc, cur, wr, wc, fr, fq, lds, wid, lane); S.done(cur); }
#undef PG8_SA
#undef PG8_SB
#undef PG8_STAGE
#undef PG8_LDA
#undef PG8_LDB
#undef PG8_MMA
#undef PG8_WAIT_V
#undef PG8_WAIT_L
#undef PG8_BAR
#undef PG8_SCHED
}
}
namespace att {
#define LAS3 __attribute__((address_space(3)))
typedef unsigned short bf16_t;
typedef short bf16x8 __attribute__((ext_vector_type(8)));
typedef short s16x4 __attribute__((ext_vector_type(4)));
typedef float f32x16 __attribute__((ext_vector_type(16)));
typedef float f32x4 __attribute__((ext_vector_type(4)));
typedef float f32x2_t __attribute__((ext_vector_type(2)));
typedef __bf16 bf16x2_t __attribute__((ext_vector_type(2)));
typedef unsigned u32x4 __attribute__((ext_vector_type(4)));
typedef unsigned u32x2 __attribute__((ext_vector_type(2)));
typedef short v4i16_t __attribute__((ext_vector_type(4)));
constexpr int SEQ = 4096;
constexpr int LDS_SBV = 0;
__device__ __forceinline__ unsigned cvtpk(float lo, float hi) { f32x2_t v = {lo, hi}; bf16x2_t b = __builtin_convertvector(v, bf16x2_t); return __builtin_bit_cast(unsigned, b); }
__device__ __forceinline__ s16x4 vtr(const LAS3 char* p) { return __builtin_bit_cast(s16x4, __builtin_amdgcn_ds_read_tr16_b64_v4i16((LAS3 v4i16_t*)p)); }
__device__ __forceinline__ void glds16(const void* gsrc, unsigned lds_dst) { unsigned keep;
    asm volatile("s_mov_b32 %0, m0\n\ts_mov_b32 m0, %2\n\ts_nop 0\n\tglobal_load_lds_dwordx4 %1, off\n\ts_mov_b32 m0, %0" : "=&s"(keep) : "v"(gsrc), "s"(lds_dst) : "memory"); }
__device__ __forceinline__ float ex2(float x) { return __builtin_amdgcn_exp2f(x); }
__device__ __forceinline__ float lg2(float x) { return __builtin_amdgcn_logf(x); }
#define ATT_MFMA(a, b, c) __builtin_amdgcn_mfma_f32_32x32x16_bf16((a), (b), (c), 0, 0, 0)
#define ATT_VFR(lo, hi) (bf16x8){lo[0], lo[1], lo[2], lo[3], hi[0], hi[1], hi[2], hi[3]}

template <int NQK>
__device__ __forceinline__ void sm_qk(f32x16& p0, f32x16& p1, const bf16x8 (&qf)[NQK], const LAS3 char* ks, const int (&ko)[NQK]) {
    constexpr int H = NQK / 2;
    bf16x8 kf[2][H][2];
#pragma unroll
    for (int j = 0; j < H; ++j) { kf[0][j][0] = *(const LAS3 bf16x8*)(ks + ko[j]); kf[0][j][1] = *(const LAS3 bf16x8*)(ks + ko[j] + (j < 4 ? 4096 : 2048)); }
    __builtin_amdgcn_sched_barrier(0);
#pragma unroll
    for (int j = 0; j < H; ++j) { kf[1][j][0] = *(const LAS3 bf16x8*)(ks + ko[H + j]); kf[1][j][1] = *(const LAS3 bf16x8*)(ks + ko[H + j] + ((H + j) < 4 ? 4096 : 2048)); }
    p0 = f32x16{}; p1 = f32x16{};
#pragma unroll
    for (int j = 0; j < H; ++j) { p0 = ATT_MFMA(kf[0][j][0], qf[j], p0); p1 = ATT_MFMA(kf[0][j][1], qf[j], p1); }
    __builtin_amdgcn_sched_barrier(0);
#pragma unroll
    for (int j = 0; j < H; ++j) { p0 = ATT_MFMA(kf[1][j][0], qf[H + j], p0); p1 = ATT_MFMA(kf[1][j][1], qf[H + j], p1); }
    __builtin_amdgcn_sched_barrier(0);
}
template <int NV>
__device__ __forceinline__ void sm_softmax_pv(f32x16 (&o)[NV], float& m_ref, float& l_run, f32x16& p0, f32x16& p1, const LAS3 char* vb) {
    s16x4 vl[2][NV], vh[2][NV];
#pragma unroll
    for (int d0 = 0; d0 < NV; ++d0) { vl[0][d0] = vtr(vb + d0 * 4096); vh[0][d0] = vtr(vb + d0 * 4096 + 512); }
    float mx = fmaxf(p0[0], p1[0]);
#pragma unroll
    for (int r = 1; r < 16; ++r) mx = fmaxf(fmaxf(mx, p0[r]), p1[r]);
    mx = x32_max(mx);
    if (__any(mx > m_ref + 8.0f)) {
        const float mn = fmaxf(m_ref, mx), alpha = ex2(m_ref - mn); m_ref = mn; l_run *= alpha;
#pragma unroll
        for (int d0 = 0; d0 < NV; ++d0)
#pragma unroll
            for (int r = 0; r < 16; ++r) o[d0][r] *= alpha;
    }
    float s = 0.f;
#pragma unroll
    for (int r = 0; r < 16; ++r) { p0[r] = ex2(p0[r] - m_ref); p1[r] = ex2(p1[r] - m_ref); s += p0[r] + p1[r]; }
    l_run += s;
    u32x4 pw[4];
#pragma unroll
    for (int i = 0; i < 4; ++i) { pw[0][i] = cvtpk(p0[2 * i], p0[2 * i + 1]); pw[1][i] = cvtpk(p0[8 + 2 * i], p0[9 + 2 * i]); pw[2][i] = cvtpk(p1[2 * i], p1[2 * i + 1]); pw[3][i] = cvtpk(p1[8 + 2 * i], p1[9 + 2 * i]); }
    __builtin_amdgcn_sched_barrier(0);
#pragma unroll
    for (int ks = 0; ks < 4; ++ks) {
        if (ks < 3) {
#pragma unroll
            for (int d0 = 0; d0 < NV; ++d0) { vl[(ks + 1) & 1][d0] = vtr(vb + d0 * 4096 + (ks + 1) * 1024); vh[(ks + 1) & 1][d0] = vtr(vb + d0 * 4096 + (ks + 1) * 1024 + 512); } }
#pragma unroll
        for (int d0 = 0; d0 < NV; ++d0) o[d0] = ATT_MFMA(ATT_VFR(vl[ks & 1][d0], vh[ks & 1][d0]), __builtin_bit_cast(bf16x8, pw[ks]), o[d0]);
        __builtin_amdgcn_sched_barrier(0); }
}

template <int NQK, int NV>
__device__ __forceinline__ void sm_pass(f32x16 (&o)[NV], const bf16x8 (&qf)[NQK], int nt_wg, int nt_wave, const bf16_t* k0p, int k0pitch, const bf16_t* k1p, int k1pitch,
                                        const bf16_t* vp, int vpitch, LAS3 char* lds, int wave, int lane) {
    static_assert((NQK == 4 && NV == 4) || (NQK == 6 && NV == 2), "3 DMA instructions per wave per tile");
    constexpr int NKW = (NQK == 4) ? 1 : 2, NVW = NV / 2;
    constexpr int KSLOT = 12288, VSLOT = 16384, VBASE = 3 * KSLOT;
    const int r32 = lane & 31, hi = lane >> 5;
    const LAS3 char* kp = lds;
    const unsigned lds0 = (unsigned)(unsigned long)lds;
    int ko[NQK];
#pragma unroll
    for (int j = 0; j < NQK; ++j) ko[j] = (j < 4) ? r32 * 128 + (((2 * j + hi) ^ ((r32 >> 1) & 7)) * 16) : 8192 + r32 * 64 + (((2 * (j - 4) + hi) ^ ((r32 >> 2) & 3)) * 16);
    const LAS3 char* vb = lds + VBASE + ((lane >> 4) & 1) * 32 + (lane & 3) * 8 + (4 * hi + ((lane & 15) >> 2)) * 64;
    float m_ref = -1e30f, l_run = 0.f;
#pragma unroll
    for (int d0 = 0; d0 < NV; ++d0) o[d0] = f32x16{};
    const int krow0 = 8 * wave + (lane >> 3), krow1 = 16 * (wave & 3) + (lane >> 2);
    const int koff0 = (krow0 * k0pitch + (((lane & 7) ^ ((krow0 >> 1) & 7)) * 8)) * 2, koff1 = (krow1 * k1pitch + (((lane & 3) ^ ((krow1 >> 2) & 3)) * 8)) * 2;
    const int voffl = ((lane >> 2) * vpitch + (lane & 3) * 8) * 2;
#define ATT_DMA_K(t, slot) do { \
        glds16((const char*)k0p + (size_t)(t) * 64 * k0pitch * 2 + koff0, (unsigned)__builtin_amdgcn_readfirstlane((int)(lds0 + (slot) * KSLOT + wave * 1024))); \
        if (NQK == 6) glds16((const char*)k1p + (size_t)(t) * 64 * k1pitch * 2 + koff1, (unsigned)__builtin_amdgcn_readfirstlane((int)(lds0 + (slot) * KSLOT + 8192 + (wave & 3) * 1024))); } while (0)
#define ATT_DMA_V(t, slot) do { _Pragma("unroll") for (int i = 0; i < NVW; ++i) { const int ch = wave + 8 * i; \
        const char* src = (const char*)vp + ((size_t)((t) * 64 + (ch & 3) * 16) * vpitch + (ch >> 2) * 32) * 2 + voffl; \
        glds16(src, (unsigned)__builtin_amdgcn_readfirstlane((int)(lds0 + VBASE + (slot) * VSLOT + ch * 1024))); } } while (0)
#define ATT_WAITBAR(N) asm volatile("s_waitcnt vmcnt(" #N ") lgkmcnt(0)\n\ts_barrier" ::: "memory")
    f32x16 a0, a1, b0, b1;
    ATT_WAITBAR(0);
    ATT_DMA_K(0, 0); ATT_DMA_V(0, 0); ATT_DMA_K(1, 1); ATT_DMA_V(1, 1); ATT_DMA_K(2, 2);
    ATT_WAITBAR(3);
    sm_qk<NQK>(a0, a1, qf, kp, ko);
    int s0 = 0, s1 = 1, s2 = 2;
#define ATT_STEP(tt, C0, C1, N0, N1, QKFIRST) do { \
        if ((tt) + 2 < nt_wg) ATT_WAITBAR(3); else ATT_WAITBAR(0); \
        if ((tt) + 3 < nt_wg) ATT_DMA_K((tt) + 3, s0); \
        if ((tt) + 2 < nt_wg) ATT_DMA_V((tt) + 2, s2); \
        if (QKFIRST) { sm_qk<NQK>(N0, N1, qf, kp + s1 * KSLOT, ko); if ((tt) < nt_wave) sm_softmax_pv<NV>(o, m_ref, l_run, C0, C1, vb + s0 * VSLOT); } \
        else { if ((tt) < nt_wave) sm_softmax_pv<NV>(o, m_ref, l_run, C0, C1, vb + s0 * VSLOT); sm_qk<NQK>(N0, N1, qf, kp + s1 * KSLOT, ko); } \
        { const int s_ = s0; s0 = s1; s1 = s2; s2 = s_; } } while (0)
    if (wave < 4) { for (int t = 0; t < nt_wg; t += 2) { ATT_STEP(t, a0, a1, b0, b1, true); ATT_STEP(t + 1, b0, b1, a0, a1, true); } }
    else          { for (int t = 0; t < nt_wg; t += 2) { ATT_STEP(t, a0, a1, b0, b1, false); ATT_STEP(t + 1, b0, b1, a0, a1, false); } }
#undef ATT_STEP
#undef ATT_DMA_K
#undef ATT_DMA_V
#undef ATT_WAITBAR
    const float l = x32_sum(l_run), inv = 1.0f / l;
#pragma unroll
    for (int d0 = 0; d0 < NV; ++d0)
#pragma unroll
        for (int r = 0; r < 16; ++r) o[d0][r] *= inv;
}

template <int NV, class Pack>
__device__ __forceinline__ void store_rows_staged(bf16_t* dst  , int ldd, LAS3 char* stg, int lane, const Pack& pack) {
    constexpr int ND = 32 * NV, PITCH = 2 * ND + 16, PPR = ND / 8;
    const int r32 = lane & 31, hi = lane >> 5;
#pragma unroll
    for (int d0 = 0; d0 < NV; ++d0)
#pragma unroll
        for (int r4 = 0; r4 < 4; ++r4) *(LAS3 u32x2*)(stg + r32 * PITCH + (32 * d0 + 8 * r4 + 4 * hi) * 2) = pack(d0, r4);
    asm volatile("s_waitcnt lgkmcnt(0)" ::: "memory");
#pragma unroll
    for (int it = 0; it < (32 * PPR) / 64; ++it) { const int idx = it * 64 + lane, row = idx / PPR, c = idx % PPR;
        const u32x4 v = *(const LAS3 u32x4*)(stg + row * PITCH + c * 16); *(u32x4*)(dst + (size_t)row * ldd + c * 8) = v; }
}
__device__ __forceinline__ void diff_unit(int b, int h, int qb, const bf16_t* P, int ldp, bf16_t* MG, const float* subln, float lam, float one_m_li, f32x4* stash  , LAS3 char* lds, int tid, int lane, int w) {
    const int r32 = lane & 31, hi = lane >> 5;
    const size_t row = (size_t)b * SEQ + qb * 256 + w * 32 + r32;
    const bf16_t* Pb = P + (size_t)b * SEQ * ldp;
    const int nt_wg = 4 * qb + 4, nt_wave = 4 * qb + (w >> 1) + 1;
    bf16x8 qf[4]; f32x16 o1[4];
#pragma unroll
    for (int j = 0; j < 4; ++j) qf[j] = *(const bf16x8*)(P + row * ldp + h * 128 + 16 * j + 8 * hi);
    sm_pass<4, 4>(o1, qf, nt_wg, nt_wave, Pb + 512 + h * 128, ldp, Pb, ldp, Pb + 1024 + h * 128, ldp, lds, w, lane);
#pragma unroll
    for (int d0 = 0; d0 < 4; ++d0)
#pragma unroll
        for (int r4 = 0; r4 < 4; ++r4) stash[(d0 * 4 + r4) * 64] = (f32x4){o1[d0][4 * r4], o1[d0][4 * r4 + 1], o1[d0][4 * r4 + 2], o1[d0][4 * r4 + 3]};
#pragma unroll
    for (int j = 0; j < 4; ++j) qf[j] = *(const bf16x8*)(P + row * ldp + h * 128 + 64 + 16 * j + 8 * hi);
    sm_pass<4, 4>(o1, qf, nt_wg, nt_wave, Pb + 512 + h * 128 + 64, ldp, Pb, ldp, Pb + 1024 + h * 128, ldp, lds, w, lane);
    float ss = 0.f;
#pragma unroll
    for (int d0 = 0; d0 < 4; ++d0)
#pragma unroll
        for (int r4 = 0; r4 < 4; ++r4) { const f32x4 a1 = stash[(d0 * 4 + r4) * 64];
#pragma unroll
            for (int e = 0; e < 4; ++e) { const float y = a1[e] - lam * o1[d0][4 * r4 + e]; o1[d0][4 * r4 + e] = y; ss += y * y; } }
    ss = x32_sum(ss);
    const float rn = one_m_li / sqrtf(ss * (1.0f / 128.0f) + 1e-6f);
    asm volatile("s_waitcnt lgkmcnt(0)\n\ts_barrier" ::: "memory");
    store_rows_staged<4>(MG + (row - r32) * 1024 + h * 128, 1024, lds + w * 8704, lane, [&](int d0, int r4) { const int d = 32 * d0 + 8 * r4 + 4 * hi; const f32x4 g = *(const f32x4*)(subln + d);
        u32x2 wv; wv.x = cvtpk(o1[d0][4 * r4] * rn * g[0], o1[d0][4 * r4 + 1] * rn * g[1]); wv.y = cvtpk(o1[d0][4 * r4 + 2] * rn * g[2], o1[d0][4 * r4 + 3] * rn * g[3]); return wv; });
}
__device__ __forceinline__ void mla_unit(int b, int h, int qb, const bf16_t* P, int ldp, const bf16_t* QB, const bf16_t* KV, bf16_t* MG, LAS3 char* lds, int tid, int lane, int w) {
    const int r32 = lane & 31, hi = lane >> 5;
    const size_t row = (size_t)b * SEQ + qb * 256 + w * 32 + r32;
    const bf16_t* Pb = P + (size_t)b * SEQ * ldp; const bf16_t* KVb = KV + (size_t)b * SEQ * 512;
    const int nt_wg = 4 * qb + 4, nt_wave = 4 * qb + (w >> 1) + 1;
    bf16x8 qf[6]; f32x16 o[2];
#pragma unroll
    for (int j = 0; j < 6; ++j) qf[j] = *(const bf16x8*)(QB + row * 512 + h * 128 + 16 * j + 8 * hi);
    sm_pass<6, 2>(o, qf, nt_wg, nt_wave, KVb + h * 128, 512, Pb + 1920, ldp, KVb + h * 128 + 64, 512, lds, w, lane);
    asm volatile("s_waitcnt lgkmcnt(0)\n\ts_barrier" ::: "memory");
    store_rows_staged<2>(MG + (row - r32) * 1024 + 512 + h * 64, 1024, lds + w * 4608, lane, [&](int d0, int r4) {
        u32x2 wv; wv.x = cvtpk(o[d0][4 * r4], o[d0][4 * r4 + 1]); wv.y = cvtpk(o[d0][4 * r4 + 2], o[d0][4 * r4 + 3]); return wv; });
}
constexpr float SB_STOP = 152.0f;
__device__ __forceinline__ void sb_unit(int b, int h, int qb32, const bf16_t* P, int ldp, bf16_t* MG, LAS3 char* vl, int lane) {
    const int r32 = lane & 31, hi = lane >> 5;
    const size_t row = (size_t)b * SEQ + qb32 * 32 + r32;
    const bf16_t* Pb = P + (size_t)b * SEQ * ldp;
    const int T = qb32 >> 1, qrel = (qb32 & 1) * 32 + r32;
    bf16x8 qf[4]; f32x16 o[2]; o[0] = f32x16{}; o[1] = f32x16{};
#pragma unroll
    for (int j = 0; j < 4; ++j) qf[j] = *(const bf16x8*)(P + row * ldp + 2048 + h * 64 + 16 * j + 8 * hi);
    const LAS3 char* vb = vl + ((lane >> 4) & 1) * 32 + (lane & 3) * 8 + (4 * hi + ((lane & 15) >> 2)) * 64;
    float R = 0.f;
    const int voffs = ((lane >> 3) * ldp + 2560 + h * 64 + (lane & 7) * 8) * 2;
    const int koffs = (r32 * ldp + 2304 + h * 64 + 8 * hi) * 2;
    u32x4 vr[8]; bf16x8 kf[4][2];
#define SB_FETCH(tt) do { const char* kt_ = (const char*)(Pb + (size_t)((tt) * 64) * ldp); \
        _Pragma("unroll") for (int it = 0; it < 8; ++it) vr[it] = *(const u32x4*)(kt_ + (size_t)(8 * it) * ldp * 2 + voffs); \
        _Pragma("unroll") for (int j = 0; j < 4; ++j) { kf[j][0] = *(const bf16x8*)(kt_ + koffs + 32 * j); kf[j][1] = *(const bf16x8*)(kt_ + (size_t)32 * ldp * 2 + koffs + 32 * j); } } while (0)
    SB_FETCH(T);
    for (int t = T; t >= 0; --t) {
        f32x16 p0 = {}, p1 = {};
#pragma unroll
        for (int j = 0; j < 4; ++j) { p0 = ATT_MFMA(kf[j][0], qf[j], p0); p1 = ATT_MFMA(kf[j][1], qf[j], p1); }
        asm volatile("s_waitcnt lgkmcnt(0)" ::: "memory");
#pragma unroll
        for (int it = 0; it < 8; ++it) { const int idx = it * 64 + lane, key = idx >> 3, c8 = idx & 7; *(LAS3 u32x4*)(vl + (c8 >> 2) * 4096 + key * 64 + (c8 & 3) * 16) = vr[it]; }
        if (t > 0) SB_FETCH(t - 1);
        const bool diag = (t == T);
        f32x16 s0, s1;
#pragma unroll
        for (int r = 0; r < 16; ++r) { const int kk = (r & 3) + 8 * (r >> 2) + 4 * hi;
            const float z0 = p0[r], z1 = p1[r];
            float a0 = fmaxf(z0, 0.f) + lg2(1.0f + ex2(-fabsf(z0))), a1 = fmaxf(z1, 0.f) + lg2(1.0f + ex2(-fabsf(z1)));
            if (diag && !(kk < qrel)) a0 = 0.f;
            if (diag && !(kk + 32 < qrel)) a1 = 0.f;
            s0[r] = a0; s1[r] = a1; }
        float own[8], oth[8];
#pragma unroll
        for (int i = 0; i < 4; ++i) { own[i] = (s0[4 * i] + s0[4 * i + 1]) + (s0[4 * i + 2] + s0[4 * i + 3]); own[4 + i] = (s1[4 * i] + s1[4 * i + 1]) + (s1[4 * i + 2] + s1[4 * i + 3]); }
#pragma unroll
        for (int i = 0; i < 8; ++i) oth[i] = x32_other(own[i], hi);
        float Aown[8]; float run = 0.f;
#pragma unroll
        for (int i = 7; i >= 0; --i) { const float Se = hi ? oth[i] : own[i], So = hi ? own[i] : oth[i];
            const float A_odd = run; run += So; const float A_even = run; run += Se;
            Aown[i] = hi ? A_odd : A_even; }
        const float tile_sum = run;
#pragma unroll
        for (int i = 0; i < 4; ++i) {
            float af0 = Aown[i] + R, af1 = Aown[4 + i] + R;
#pragma unroll
            for (int e = 3; e >= 0; --e) { const int r = 4 * i + e; const int kk = e + 8 * i + 4 * hi;
                const float sp0 = s0[r], sp1 = s1[r];
                float w0 = ex2(p0[r] - sp0 - af0), w1 = ex2(p1[r] - sp1 - af1);
                if (diag && !(kk < qrel)) w0 = 0.f;
                if (diag && !(kk + 32 < qrel)) w1 = 0.f;
                af0 += sp0; af1 += sp1; p0[r] = w0; p1[r] = w1; } }
        R += tile_sum;
        u32x4 pw[4];
#pragma unroll
        for (int i = 0; i < 4; ++i) { pw[0][i] = cvtpk(p0[2 * i], p0[2 * i + 1]); pw[1][i] = cvtpk(p0[8 + 2 * i], p0[9 + 2 * i]); pw[2][i] = cvtpk(p1[2 * i], p1[2 * i + 1]); pw[3][i] = cvtpk(p1[8 + 2 * i], p1[9 + 2 * i]); }
        asm volatile("s_waitcnt lgkmcnt(0)" ::: "memory");
#pragma unroll
        for (int d0 = 0; d0 < 2; ++d0)
#pragma unroll
            for (int ks = 0; ks < 4; ++ks) { const s16x4 lo = vtr(vb + d0 * 4096 + ks * 1024), hi4 = vtr(vb + d0 * 4096 + ks * 1024 + 512);
                o[d0] = ATT_MFMA(ATT_VFR(lo, hi4), __builtin_bit_cast(bf16x8, pw[ks]), o[d0]); }
        if (__all(R >= SB_STOP)) break;
    }
#undef SB_FETCH
    asm volatile("s_waitcnt lgkmcnt(0)" ::: "memory");
    store_rows_staged<2>(MG + (row - r32) * 1024 + 768 + h * 64, 1024, vl, lane, [&](int d0, int r4) {
        u32x2 wv; wv.x = cvtpk(o[d0][4 * r4], o[d0][4 * r4 + 1]); wv.y = cvtpk(o[d0][4 * r4 + 2], o[d0][4 * r4 + 3]); return wv; });
}
}
#define LAS __attribute__((address_space(3)))
typedef unsigned short bf16;
typedef unsigned v4u __attribute__((ext_vector_type(4)));
typedef float f32x4 __attribute__((ext_vector_type(4)));
constexpr int NWAVES = 8;
constexpr int BATCH = 8, SEQ = 4096, D = 1024, M = BATCH * SEQ, DFF = 2816, DEPTH = 2;
constexpr int NIN = 2816  , IN_SRC = 2720;
constexpr size_t MiB = 1u << 20;
constexpr size_t WS_COSD = 1 * MiB, WS_SIND = WS_COSD + 128 * 1024, WS_COSM = WS_SIND + 128 * 1024, WS_SINM = WS_COSM + 256 * 1024;
constexpr size_t WS_PART = 2 * MiB;
constexpr size_t WS_PARTQ = 4 * MiB;
constexpr size_t WS_PARTKV = 4 * MiB + 512 * 1024;
constexpr size_t WS_W = 8 * MiB, WS_WL = 42 * MiB;
constexpr size_t W_GU1 = 0, W_D1 = 11 * MiB, W_IN = W_D1 + 5632 * 1024, W_UQ = W_IN + 5632 * 1024, W_UKV = W_UQ + 256 * 1024, W_OUT = W_UKV + 256 * 1024, W_GU2 = W_OUT + 2 * MiB, W_D2 = W_GU2 + 11 * MiB;
static_assert(W_D2 + 5632 * 1024 <= WS_WL, "weight map");
constexpr size_t WS_XB = 96 * MiB;
constexpr size_t WS_MG = 160 * MiB;
constexpr size_t WS_QB = 224 * MiB;
constexpr size_t WS_KV = 256 * MiB;
constexpr size_t WS_HP = 288 * MiB;
constexpr size_t WS_STASH = 464 * MiB;
constexpr size_t WS_END = 496 * MiB;
constexpr int RING_BYTES = 131072, LDS_BYTES = 147456;

__device__ __forceinline__ unsigned f2bf(float f) { unsigned u = __builtin_bit_cast(unsigned, f); return (u + 0x7fffu + ((u >> 16) & 1u)) >> 16; }
__device__ __forceinline__ unsigned pk2(float lo, float hi) { return f2bf(lo) | (f2bf(hi) << 16); }
__device__ __forceinline__ int ropeperm(int p, int half) { return ((p >> 2) & 1) * half + 4 * (p >> 3) + (p & 3); }
__device__ __forceinline__ int src_col(int kind, int n, int nsrc, int& mat) {
    mat = 0;
    if (kind == 0) return n < nsrc ? n : -1;
    if (kind == 1) { const int pn = n >> 8, w = n & 255; mat = w >> 7; return pn * 128 + (w & 127); }
    if (kind == 2) { const int tile = n >> 8, w = n & 255;
        if (tile < 4) { const int d = n & 63; return d < 16 ? (n & ~63) + ropeperm(d, 8) : n; }
        if (tile < 7) return n;
        if (tile == 7) { if (w < 128) return 1792 + w; if (w < 160) return 1920 + ropeperm(w - 128, 16); return -1; }
        return n - 96; }
    { const int head = n >> 7, w = n & 127; if (w < 64) return head * 96 + w; if (w < 96) return head * 96 + 64 + ropeperm(w - 64, 16); return -1; }
}
__device__ __forceinline__ void wt_item(const float* W0, const float* W1, const float* gain, bf16* WT, int Ksrc, int Kdst, int Nsrc, int Ndst, int kind, LAS float* scr  , int item, int lane) {
    const int nblk = Ndst / 64, kb = item / nblk, nb = item % nblk, k0 = 64 * kb, n0 = 64 * nb;
    int mat; const int sc = src_col(kind, n0 + lane, Nsrc, mat); const float* W = mat ? W1 : W0;
    const bool live = (sc >= 0) && (k0 < Ksrc);
    const float* wp = W + (size_t)k0 * Nsrc + (live ? sc : 0);
#pragma unroll 16
    for (int kk = 0; kk < 64; ++kk) { float v = 0.f; if (live) v = wp[(size_t)kk * Nsrc]; scr[kk * 65 + lane] = v; }
    asm volatile("s_waitcnt lgkmcnt(0)" ::: "memory");
    const int c = lane & 7;
    f32x4 g0 = {1.f, 1.f, 1.f, 1.f}, g1 = {1.f, 1.f, 1.f, 1.f};
    if (gain && k0 < Ksrc) { g0 = *(const f32x4*)(gain + k0 + 8 * c); g1 = *(const f32x4*)(gain + k0 + 8 * c + 4); }
#pragma unroll
    for (int j = 0; j < 8; ++j) { const int n = (lane >> 3) + 8 * j; const LAS float* s = scr + (8 * c) * 65 + n;
        v4u o; o.x = pk2(s[0 * 65] * g0[0], s[1 * 65] * g0[1]); o.y = pk2(s[2 * 65] * g0[2], s[3 * 65] * g0[3]); o.z = pk2(s[4 * 65] * g1[0], s[5 * 65] * g1[1]); o.w = pk2(s[6 * 65] * g1[2], s[7 * 65] * g1[3]);
        *(v4u*)(WT + (size_t)(n0 + n) * Kdst + k0 + 8 * c) = o; }
    asm volatile("s_waitcnt lgkmcnt(0)" ::: "memory");
}
__device__ __forceinline__ void wt_tile(const float* W0, const float* W1, const float* gain, bf16* WT, int Ksrc, int Kdst, int Nsrc, int Ndst, int kind, LAS float* img, int tile, int wave, int lane) {
    constexpr int S = 260;
    const int nblk = Ndst / 256, kb = tile / nblk, nb = tile % nblk, k0 = 128 * kb, n0 = 256 * nb;
    int mat; const int sc = src_col(kind, n0 + 4 * lane, Nsrc, mat); const float* W = mat ? W1 : W0;
    const bool live = (sc >= 0) && (k0 < Ksrc);
    const float* wp = W + (size_t)(k0 + wave) * Nsrc + (live ? sc : 0);
    f32x4 v[16];
#pragma unroll
    for (int i = 0; i < 16; ++i) v[i] = live ? __builtin_nontemporal_load((const f32x4*)(wp + (size_t)(8 * i) * Nsrc)) : (f32x4){0.f, 0.f, 0.f, 0.f};
#pragma unroll
    for (int i = 0; i < 16; ++i) { const int kl = wave + 8 * i; const float g = (gain && k0 < Ksrc) ? gain[k0 + kl] : 1.0f; *(LAS f32x4*)(img + kl * S + 4 * lane) = v[i] * g; }
    __syncthreads();
    const int c = lane & 15, nsub = lane >> 4;
#pragma unroll
    for (int j = 0; j < 8; ++j) { const int n = 32 * j + 4 * wave + nsub; const LAS float* s = img + (8 * c) * S + n;
        v4u o; o.x = pk2(s[0 * S], s[1 * S]); o.y = pk2(s[2 * S], s[3 * S]); o.z = pk2(s[4 * S], s[5 * S]); o.w = pk2(s[6 * S], s[7 * S]);
        *(v4u*)(WT + (size_t)(n0 + n) * Kdst + k0 + 8 * c) = o; }
    __syncthreads();
}
__device__ __forceinline__ void sincos_d(float af, float& c, float& s) {
    const double a = (double)af; const double TWO_PI = 6.283185307179586476925287, INV_2PI = 0.15915494309189533576888;
    const double n = rint(a * INV_2PI); double r = a - n * TWO_PI;
    r *= 0.25; const double r2 = r * r;
    double sn = r * (1.0 + r2 * (-1.0 / 6 + r2 * (1.0 / 120 + r2 * (-1.0 / 5040 + r2 * (1.0 / 362880 + r2 * (-1.0 / 39916800 + r2 * (1.0 / 6227020800.0)))))));
    double cs = 1.0 + r2 * (-0.5 + r2 * (1.0 / 24 + r2 * (-1.0 / 720 + r2 * (1.0 / 40320 + r2 * (-1.0 / 3628800 + r2 * (1.0 / 479001600.0 + r2 * (-1.0 / 87178291200.0)))))));
#pragma unroll
    for (int i = 0; i < 2; ++i) { const double s2 = 2.0 * sn * cs, c2 = cs * cs - sn * sn; sn = s2; cs = c2; }
    c = (float)cs; s = (float)sn;
}

typedef __attribute__((address_space(1))) unsigned gu32;
#define XB_TMO      128
#define XB_XCNT(j)  (256  + 64 * (j))
#define XB_XSUB(j)  (1280 + 64 * (j))
#define XB_XGEN(j)  (2304 + 64 * (j))
#define XB_TOP      3328
#define XB_TOPGEN   3392
#define XCD_BAR_WORDS 3456
#define XB_SPIN_CAP (1u << 18)

__device__ __forceinline__ unsigned xb_ld(unsigned* p)              { return __hip_atomic_load(p, __ATOMIC_RELAXED, __HIP_MEMORY_SCOPE_AGENT); }
__device__ __forceinline__ unsigned xb_add(unsigned* p, unsigned v) { return __hip_atomic_fetch_add(p, v, __ATOMIC_RELAXED, __HIP_MEMORY_SCOPE_AGENT); }
__device__ __forceinline__ unsigned xb_xcc_id() { return (unsigned)__builtin_amdgcn_s_getreg((3 << 11) | 20) & 0xFu; }
#define XB_SPIN(cond, bar) do { unsigned _sp = 0; while (cond) { __builtin_amdgcn_s_sleep(1); \
    if ((++_sp & 255u) == 0u) { if (xb_ld(&(bar)[XB_TMO])) break; if (_sp > XB_SPIN_CAP) { atomicAdd(&(bar)[XB_TMO], 1u); break; } } } } while (0)

struct XcdBarrier {
    unsigned* bar; unsigned x;
    volatile LAS unsigned* st;
};

__device__ __forceinline__ XcdBarrier xcd_barrier_post(unsigned* bar, volatile LAS unsigned* st, bool leader) {
    XcdBarrier b; b.bar = bar; b.x = xb_xcc_id(); b.st = st;
    if (leader) (void)xb_add(&bar[XB_XCNT(b.x)], 1u);
    return b;
}
__device__ __forceinline__ void xcd_barrier_complete(unsigned* bar, unsigned x, unsigned& nloc, unsigned& nx) {
    const unsigned G = gridDim.x * gridDim.y * gridDim.z;
    unsigned sum, cnt, mine, sp = 0u;
    for (;;) {
        sum = 0u; cnt = 0u; mine = 0u;
#pragma unroll
        for (unsigned j = 0; j < 16; ++j) { const unsigned c = xb_ld(&bar[XB_XCNT(j)]); sum += c; cnt += (c > 0u) ? 1u : 0u; mine = (j == x) ? c : mine; }
        if (sum == G) break;
        __builtin_amdgcn_s_sleep(1);
        if ((++sp & 255u) == 0u) { if (xb_ld(&bar[XB_TMO])) break; if (sp > XB_SPIN_CAP) { atomicAdd(&bar[XB_TMO], 1u); break; } }
    }
    nloc = mine > 0u ? mine : 1u; nx = cnt > 0u ? cnt : 1u;
}

__device__ __forceinline__ void xcd_barrier(const XcdBarrier& b, bool leader) {
    asm volatile("s_waitcnt vmcnt(0)" ::: "memory");
    __syncthreads();
    if (leader) {
        unsigned* bar = b.bar;
        __builtin_amdgcn_s_waitcnt(0);
        unsigned nloc = b.st[0], nx = b.st[1];
        if (nloc == 0u) { xcd_barrier_complete(bar, b.x, nloc, nx); b.st[0] = nloc; b.st[1] = nx; }
        const unsigned old = xb_add(&bar[XB_XSUB(b.x)], 1u);
        const unsigned gen = old / nloc;
        if (old + 1u == (gen + 1u) * nloc) {
            __builtin_amdgcn_fence(__ATOMIC_RELEASE, "agent");
            asm volatile("s_waitcnt vmcnt(0)" ::: "memory");
            const unsigned og = xb_add(&bar[XB_TOP], 1u);
            const unsigned tg = og / nx;
            if (og + 1u == (tg + 1u) * nx) xb_add(&bar[XB_TOPGEN], 1u);
            else XB_SPIN(xb_ld(&bar[XB_TOPGEN]) == tg, bar);
            __builtin_amdgcn_fence(__ATOMIC_ACQUIRE, "agent");
            xb_add(&bar[XB_XGEN(b.x)], 1u);
            asm volatile("s_waitcnt vmcnt(0)" ::: "memory");
        } else {
            XB_SPIN(xb_ld(&bar[XB_XGEN(b.x)]) == gen, bar);
            __builtin_amdgcn_fence(__ATOMIC_ACQUIRE, "agent");
            asm volatile("s_waitcnt vmcnt(0)" ::: "memory");
        }
    }
    __syncthreads();
}


struct Args { const float* in[22]; float* out; unsigned char* ws; };

__global__ void __launch_bounds__(NWAVES * 64, 2) fwd_mega(Args a) {
    extern __shared__ __attribute__((aligned(16))) unsigned char lds_raw[];
    cg::grid_group grid = cg::this_grid();
    LAS unsigned char* lds = (LAS unsigned char*)lds_raw;
    const int wave = __builtin_amdgcn_readfirstlane((int)threadIdx.x >> 6);
#define FRESH_LANE() ({ unsigned m_ = ~0u; asm volatile("" : "+s"(m_)); int l_ = (int)__builtin_amdgcn_mbcnt_hi(m_, __builtin_amdgcn_mbcnt_lo(m_, 0u)); l_; })
    volatile LAS unsigned* MISC = (volatile LAS unsigned*)(lds + RING_BYTES + 15360);
    { const int ln0 = FRESH_LANE(); if (wave == 0 && ln0 < 2) MISC[ln0] = 0u;
      if (blockIdx.x == 0) { unsigned* bw = (unsigned*)a.ws; for (int i = wave * 64 + ln0; i < XCD_BAR_WORDS; i += NWAVES * 64) bw[i] = 0u; } }
    __syncthreads();
    const int G = gridDim.x, bx = blockIdx.x; const int vcu = (G % 8 == 0) ? (bx % 8) * (G / 8) + bx / 8 : bx;
#define LOCALS() \
    int z_ = 0; asm volatile("" : "+s"(z_)); const float* const* in = a.in + z_; \
    unsigned char* ws = a.ws + z_; float* out = a.out + z_; const float* x = in[0]; \
    float* cosd = (float*)(ws + WS_COSD); float* sind = (float*)(ws + WS_SIND); float* cosm = (float*)(ws + WS_COSM); float* sinm = (float*)(ws + WS_SINM); \
    float* part = (float*)(ws + WS_PART); float* partq = (float*)(ws + WS_PARTQ); float* partkv = (float*)(ws + WS_PARTKV); \
    bf16* XB = (bf16*)(ws + WS_XB); bf16* MG = (bf16*)(ws + WS_MG); bf16* QB = (bf16*)(ws + WS_QB); bf16* KV = (bf16*)(ws + WS_KV); bf16* HP = (bf16*)(ws + WS_HP); \
    (void)x; (void)out; (void)cosd; (void)sind; (void)cosm; (void)sinm; (void)part; (void)partq; (void)partkv; (void)XB; (void)MG; (void)QB; (void)KV; (void)HP
    const int gw = vcu * NWAVES + wave, NGW = G * NWAVES;

    {
        LOCALS();
        const int lane = FRESH_LANE(), tid = wave * 64 + lane;
        LAS float* scr = (LAS float*)(lds + wave * 16640);
        constexpr int I_GU = 16 * 88, I_D = 44 * 16, I_IN = 16 * 44, I_UQ = 4 * 8, I_UKV = 4 * 8, I_OUT = 16 * 16;
        constexpr int I_LAYER = 2 * I_GU + 2 * I_D + I_IN + I_UQ + I_UKV + I_OUT;
        constexpr int T_GU = 8 * 22, T_D = 22 * 4, T_IN = 8 * 11, T_UQ = 2 * 2, T_UKV = 2 * 2, T_OUT = 8 * 4, T_LAYER = 2 * T_GU + 2 * T_D + T_IN + T_UQ + T_UKV + T_OUT;
        LAS float* img = (LAS float*)lds;
        for (int tl = vcu; tl < DEPTH * T_LAYER; tl += G) {
            const int l = tl / T_LAYER; int r = tl % T_LAYER; bf16* wl = (bf16*)(ws + WS_W + l * WS_WL);
            if (r < T_GU) { wt_tile(in[2] + (size_t)l * D * DFF, in[3] + (size_t)l * D * DFF, in[1] + l * D, (bf16*)((char*)wl + W_GU1), D, D, DFF, 2 * DFF, 1, img, r, wave, lane); continue; } r -= T_GU;
            if (r < T_D) { wt_tile(in[4] + (size_t)l * DFF * D, nullptr, nullptr, (bf16*)((char*)wl + W_D1), DFF, DFF, D, D, 0, img, r, wave, lane); continue; } r -= T_D;
            if (r < T_IN) { wt_tile(in[6] + (size_t)l * D * IN_SRC, nullptr, in[5] + l * D, (bf16*)((char*)wl + W_IN), D, D, IN_SRC, NIN, 2, img, r, wave, lane); continue; } r -= T_IN;
            if (r < T_UQ) { wt_tile(in[13] + (size_t)l * 256 * 384, nullptr, in[12] + l * 256, (bf16*)((char*)wl + W_UQ), 256, 256, 384, 512, 3, img, r, wave, lane); continue; } r -= T_UQ;
            if (r < T_UKV) { wt_tile(in[15] + (size_t)l * 128 * 512, nullptr, in[14] + l * 128, (bf16*)((char*)wl + W_UKV), 128, 256, 512, 512, 0, img, r, wave, lane); continue; } r -= T_UKV;
            if (r < T_OUT) { wt_tile(in[16] + (size_t)l * D * D, nullptr, nullptr, (bf16*)((char*)wl + W_OUT), D, D, D, D, 0, img, r, wave, lane); continue; } r -= T_OUT;
            if (r < T_GU) { wt_tile(in[18] + (size_t)l * D * DFF, in[19] + (size_t)l * D * DFF, in[17] + l * D, (bf16*)((char*)wl + W_GU2), D, D, DFF, 2 * DFF, 1, img, r, wave, lane); continue; } r -= T_GU;
            wt_tile(in[20] + (size_t)l * DFF * D, nullptr, nullptr, (bf16*)((char*)wl + W_D2), DFF, DFF, D, D, 0, img, r, wave, lane);
        }
        for (int i = bx * 512 + tid; i < SEQ * 24; i += G * 512) {
            const int pos = i / 24, k = i % 24; float c, s;
            if (k < 8) { const float inv = (float)exp2(-(double)(2 * k) / 16.0 * 18.931568569324174  ); sincos_d((float)pos * inv, c, s); cosd[pos * 8 + k] = c; sind[pos * 8 + k] = s; }
            else { const int kk = k - 8; const float inv = (float)exp2(-(double)(2 * kk) / 32.0 * 18.931568569324174); sincos_d((float)pos * inv, c, s); cosm[pos * 16 + kk] = c; sinm[pos * 16 + kk] = s; }
        }
        for (int m0 = gw * 4; m0 < M; m0 += NGW * 4) {
            f32x4 v[4][4]; float s[4];
#pragma unroll
            for (int r = 0; r < 4; ++r) { const f32x4* xr = (const f32x4*)(x + (size_t)(m0 + r) * D) + lane;
#pragma unroll
                for (int j = 0; j < 4; ++j) v[r][j] = __builtin_nontemporal_load(xr + 64 * j); }
#pragma unroll
            for (int r = 0; r < 4; ++r) { float t = 0.f;
#pragma unroll
                for (int j = 0; j < 4; ++j) t += (v[r][j].x * v[r][j].x + v[r][j].y * v[r][j].y) + (v[r][j].z * v[r][j].z + v[r][j].w * v[r][j].w);
                s[r] = wave_sum(t); }
#pragma unroll
            for (int r = 0; r < 4; ++r) { unsigned long long* o8 = (unsigned long long*)(XB + (size_t)(m0 + r) * D) + lane;
#pragma unroll
                for (int j = 0; j < 4; ++j) o8[64 * j] = (unsigned long long)pk2(v[r][j].x, v[r][j].y) | ((unsigned long long)pk2(v[r][j].z, v[r][j].w) << 32); }
            { const int r = lane >> 4, c = lane & 15; const float sv = r == 0 ? s[0] : r == 1 ? s[1] : r == 2 ? s[2] : s[3]; part[(size_t)(m0 + r) * 16 + c] = c == 0 ? sv : 0.f; }
        }
    }
    grid.sync();
    XcdBarrier bar = xcd_barrier_post((unsigned*)a.ws, MISC, wave == 0 && FRESH_LANE() == 0);

    const float QS64 = 0.125f * 1.4426950408889634f, QS96 = 0.10206207261596575f * 1.4426950408889634f;
    for (int st = 0; st < DEPTH * 8; ++st) {
        LOCALS();
        const int l = st >> 3, k = st & 7;
        const unsigned char* wl = ws + WS_W + (size_t)l * WS_WL;
        if (0) {}
#ifndef NO_UP
        else if (k == 0 || k == 6) {
            pg8::Gemm g{XB, (const bf16*)(wl + (k == 0 ? W_GU1 : W_GU2)), M, 2 * DFF, D, D, D}; pg8::StaticOrder S; S.init(M, 2 * DFF, G, bx);
            LAS float* rst = (LAS float*)(lds + RING_BYTES); pg8::fill_rowscale<16>(rst, S, part, 1.0f / 1024.0f, 1.0f, wave * 64 + FRESH_LANE());
            pg8::EpiUp E{HP, rst, DFF};
            pg8::gemm_phase<pg8::EpiUp, pg8::StaticOrder, true, true>(lds, g, S, E, wave);
        }
#endif
#ifndef NO_RES
        else if (k == 1 || k == 7 || k == 5) {
            const bool wo = (k == 5);
            pg8::Gemm g{wo ? MG : HP, (const bf16*)(wl + (k == 1 ? W_D1 : k == 7 ? W_D2 : W_OUT)), M, D, wo ? D : DFF, wo ? D : DFF, wo ? D : DFF}; pg8::StaticOrder S; S.init(M, D, G, bx);
            pg8::EpiRes E{XB, part, wo ? 1.0f : 0.5f};
            pg8::gemm_phase<pg8::EpiRes, pg8::StaticOrder, true, true>(lds, g, S, E, wave);
        }
#endif
#ifndef NO_IN
        else if (k == 2) {
            pg8::Gemm g{XB, (const bf16*)(wl + W_IN), M, NIN, D, D, D}; pg8::StaticOrder S; S.init(M, NIN, G, bx);
            LAS float* rst = (LAS float*)(lds + RING_BYTES); pg8::fill_rowscale<16>(rst, S, part, 1.0f / 1024.0f, 1.0f, wave * 64 + FRESH_LANE());
            pg8::EpiIn E{HP, rst, partq, partkv, cosd, sind, cosm, sinm, NIN, QS64};
            pg8::gemm_phase<pg8::EpiIn, pg8::StaticOrder, true, true>(lds, g, S, E, wave);
        }
#endif
#ifndef NO_MLA
        else if (k == 3) {
            { pg8::Gemm g{HP + 6 * 256, (const bf16*)(wl + W_UQ), M, 512, 256, NIN, 256}; pg8::StaticOrder S; S.init(M, 512, G, bx);
              LAS float* rst = (LAS float*)(lds + RING_BYTES); pg8::fill_rowscale<4>(rst, S, partq, 1.0f / 256.0f, QS96, wave * 64 + FRESH_LANE());
              pg8::EpiMla<true> E{QB, rst, cosm, sinm, 512};
              pg8::gemm_phase<pg8::EpiMla<true>, pg8::StaticOrder, true, true>(lds, g, S, E, wave); }
            { pg8::Gemm g{HP + 7 * 256, (const bf16*)(wl + W_UKV), M, 512, 256, NIN, 256}; pg8::StaticOrder S; S.init(M, 512, G, bx);
              LAS float* rst = (LAS float*)(lds + RING_BYTES) + 1024; pg8::fill_rowscale<4>(rst, S, partkv, 1.0f / 128.0f, 1.0f, wave * 64 + FRESH_LANE());
              pg8::EpiMla<false> E{KV, rst, cosm, sinm, 512};
              pg8::gemm_phase<pg8::EpiMla<false>, pg8::StaticOrder, true, true>(lds, g, S, E, wave); }
        }
#endif
#ifndef NO_ATT
        else {
            const float li = 0.8f - 0.6f * expf(-0.3f * (float)l);
            const int lane = FRESH_LANE();
            float v1 = in[7][l * 64 + lane] * in[8][l * 64 + lane], v2 = in[9][l * 64 + lane] * in[10][l * 64 + lane];
            v1 = wave_sum(v1); v2 = wave_sum(v2);
            const float lam = expf(v1) - expf(v2) + li;
            const float* subln = in[11] + l * 128;
            for (int pr = vcu; pr < 256; pr += G) { const int bh = pr >> 3, s = pr & 7, b = bh >> 2, h = bh & 3;
#ifndef NO_DIFF
#pragma clang loop unroll(disable)
                for (int rep = 0; rep < 2; ++rep) { const int ln = FRESH_LANE();
                    f32x4* stash = (f32x4*)(ws + WS_STASH) + ((size_t)(bx * NWAVES + wave) * 16) * 64 + ln;
                    att::diff_unit(b, h, rep ? 15 - s : s, HP, NIN, MG, subln, lam, 1.0f - li, stash, (LAS char*)lds, wave * 64 + ln, ln, wave); }
#endif
#ifndef NO_MLAU
#pragma clang loop unroll(disable)
                for (int rep = 0; rep < 2; ++rep) { const int ln = FRESH_LANE();
                    att::mla_unit(b, h, rep ? 15 - s : s, HP, NIN, QB, KV, MG, (LAS char*)lds, wave * 64 + ln, ln, wave); }
#endif
            }
            __syncthreads();
#ifndef NO_SB
#pragma clang loop unroll(disable)
            for (int u = bx * NWAVES + wave; u < BATCH * 4 * 128; u += NGW) { const int b = u >> 9, h = (u >> 7) & 3, qb32 = u & 127; const int ln = FRESH_LANE();
                att::sb_unit(b, h, qb32, HP, NIN, MG, (LAS char*)lds + att::LDS_SBV + wave * 8192, ln); }
#endif
            __syncthreads();
        }
#endif
        xcd_barrier(bar, wave == 0 && FRESH_LANE() == 0);
    }
    {
        LOCALS();
        const int lane = FRESH_LANE();
        const float* gn = in[21];
        f32x4 g4[2][2];
#pragma unroll
        for (int j = 0; j < 2; ++j) { g4[j][0] = *(const f32x4*)(gn + 8 * lane + 512 * j); g4[j][1] = *(const f32x4*)(gn + 8 * lane + 512 * j + 4); }
        for (int m0 = gw * 4; m0 < M; m0 += NGW * 4) {
            v4u raw[4][2];
#pragma unroll
            for (int r = 0; r < 4; ++r)
#pragma unroll
                for (int j = 0; j < 2; ++j) raw[r][j] = *(const v4u*)(XB + (size_t)(m0 + r) * D + 8 * lane + 512 * j);
#pragma unroll
            for (int r = 0; r < 4; ++r) { f32x4 v[2][2]; float t = 0.f;
#pragma unroll
                for (int j = 0; j < 2; ++j) { const v4u w = raw[r][j];
                    v[j][0] = (f32x4){__builtin_bit_cast(float, w.x << 16), __builtin_bit_cast(float, w.x & 0xffff0000u), __builtin_bit_cast(float, w.y << 16), __builtin_bit_cast(float, w.y & 0xffff0000u)};
                    v[j][1] = (f32x4){__builtin_bit_cast(float, w.z << 16), __builtin_bit_cast(float, w.z & 0xffff0000u), __builtin_bit_cast(float, w.w << 16), __builtin_bit_cast(float, w.w & 0xffff0000u)};
                    t += (v[j][0].x * v[j][0].x + v[j][0].y * v[j][0].y) + (v[j][0].z * v[j][0].z + v[j][0].w * v[j][0].w) + (v[j][1].x * v[j][1].x + v[j][1].y * v[j][1].y) + (v[j][1].z * v[j][1].z + v[j][1].w * v[j][1].w); }
                const float rs = 1.0f / sqrtf(wave_sum(t) * (1.0f / D) + 1e-6f);
                float* xo = out + (size_t)(m0 + r) * D + 8 * lane;
#pragma unroll
                for (int j = 0; j < 2; ++j) { *(f32x4*)(xo + 512 * j) = v[j][0] * rs * g4[j][0]; *(f32x4*)(xo + 512 * j + 4) = v[j][1] * rs * g4[j][1]; } }
        }
    }
}

extern "C" void kernel_launch(void* const* d_in, const int* in_sizes, int n_in, void* d_out, int out_size, void* d_ws, size_t ws_size, hipStream_t stream) {
    static int grid = 0;
    if (grid == 0) {
        if (n_in != 22 || ws_size < WS_END) { fprintf(stderr, "kernel_launch: unexpected n_in %d / ws %zu\n", n_in, ws_size); grid = -1; return; }
        int dev = 0, cus = 0, per_cu = 0;
        (void)hipGetDevice(&dev); (void)hipDeviceGetAttribute(&cus, hipDeviceAttributeMultiprocessorCount, dev);
        (void)hipFuncSetAttribute((const void*)fwd_mega, hipFuncAttributeMaxDynamicSharedMemorySize, LDS_BYTES);
        (void)hipOccupancyMaxActiveBlocksPerMultiprocessor(&per_cu, (const void*)fwd_mega, NWAVES * 64, LDS_BYTES);
        if (per_cu < 1) { fprintf(stderr, "kernel_launch: occupancy query says %d blocks per CU\n", per_cu); per_cu = 1; }
        (void)hipGetLastError();
        grid = cus * per_cu;
    }
    if (grid < 0) return;
    Args a{};
    for (int i = 0; i < 22; ++i) a.in[i] = (const float*)d_in[i];
    a.out = (float*)d_out; a.ws = (unsigned char*)d_ws;
    void* args[] = {&a};
    hipError_t e = hipLaunchCooperativeKernel((const void*)fwd_mega, dim3(grid), dim3(NWAVES * 64), args, LDS_BYTES, stream);
    if (e != hipSuccess) fprintf(stderr, "cooperative launch failed: %s (grid %d)\n", hipGetErrorString(e), grid);
}
```

```cpp
#include <hip/hip_runtime.h>
#include <hip/hip_cooperative_groups.h>
#include <hip/hip_bf16.h>
#include <cstdio>
#include <cstdint>
namespace cg = cooperative_groups;
#define SWZ_XOR(v, o) __builtin_bit_cast(float, __builtin_amdgcn_ds_swizzle(__builtin_bit_cast(int, (float)(v)), (((o) << 10) | 0x1F)))
__device__ __forceinline__ float x32_sum(float v) { auto rr = __builtin_amdgcn_permlane32_swap(__builtin_bit_cast(unsigned, v), __builtin_bit_cast(unsigned, v), false, false); return __builtin_bit_cast(float, (unsigned)rr[0]) + __builtin_bit_cast(float, (unsigned)rr[1]); }
__device__ __forceinline__ float x32_max(float v) { auto rr = __builtin_amdgcn_permlane32_swap(__builtin_bit_cast(unsigned, v), __builtin_bit_cast(unsigned, v), false, false); return fmaxf(__builtin_bit_cast(float, (unsigned)rr[0]), __builtin_bit_cast(float, (unsigned)rr[1])); }
__device__ __forceinline__ float x32_other(float v, int hi) { auto rr = __builtin_amdgcn_permlane32_swap(__builtin_bit_cast(unsigned, v), __builtin_bit_cast(unsigned, v), false, false); return hi ? __builtin_bit_cast(float, (unsigned)rr[0]) : __builtin_bit_cast(float, (unsigned)rr[1]); }
__device__ __forceinline__ float wave_sum(float v) { v += SWZ_XOR(v, 1); v += SWZ_XOR(v, 2); v += SWZ_XOR(v, 4); v += SWZ_XOR(v, 8); v += SWZ_XOR(v, 16); return x32_sum(v); }
namespace pg8 {
#define PG8_LAS __attribute__((address_space(3)))
typedef unsigned short bf16_t;
typedef short bf16x8 __attribute__((ext_vector_type(8)));
typedef float f32x4 __attribute__((ext_vector_type(4)));
typedef unsigned u32x4 __attribute__((ext_vector_type(4)));
constexpr int BM = 256, BK = 64, HALF = 128, HTB = HALF * BK * 2  , STAGE_BYTES = 8 * HTB, NXCD = 8, WGM = 8;

__host__ __device__ __forceinline__ int lds_byte(int r, int c) { const int st = (r >> 4) * 2 + (c >> 5), rr = r & 15, cc = c & 31, ob = rr * 64 + cc * 2; return st * 1024 + (ob ^ (((ob >> 9) & 1) << 5)); }
__host__ __device__ __forceinline__ void stage_rc(int b, int& R, int& C) { const int st = b / 1024, sb = b % 1024, swz = sb ^ (((sb >> 9) & 1) << 5); R = (st >> 1) * 16 + swz / 64; C = (st & 1) * 32 + (swz % 64) / 2; }
__host__ __device__ __forceinline__ int perm32(int rho) { const int n = rho >> 4, i = rho & 15; return 8 * (i >> 2) + 4 * n + (i & 3); }

struct Unit { int pm, pn, ord; };
struct Gemm { const bf16_t* A; const bf16_t* Bt; int M, N, K, lda, ldb; };

struct StaticOrder {
    int nM, nN, nwg, G, c;
    __host__ __device__ void init(int M, int N, int G_, int c_) { nM = M / BM; nN = N / BM; nwg = nM * nN; G = G_; c = c_; }
    __host__ __device__ bool next(int i, Unit& u) const {
        const long L = (long)i * G + c; if (L >= nwg) return false;
        int wgid = (int)L; { const int q = nwg / NXCD, r = nwg % NXCD, xcd = wgid % NXCD, off = wgid / NXCD; wgid = (xcd < r ? xcd * (q + 1) : r * (q + 1) + (xcd - r) * q) + off; }
        const int nig = WGM * nN, gid = wgid / nig, fm = gid * WGM, gsz = (nM - fm) < WGM ? (nM - fm) : WGM;
        u.pm = fm + ((wgid % nig) % gsz); u.pn = (wgid % nig) / gsz; u.ord = i; return true;
    }
    __device__ __forceinline__ void a_ready(const Unit&) const {}
    __device__ __forceinline__ void done(const Unit&) const {}
};

typedef float f32x2 __attribute__((ext_vector_type(2)));
typedef __bf16 bf16x2_t __attribute__((ext_vector_type(2)));
typedef unsigned u32x2 __attribute__((ext_vector_type(2)));
__device__ __forceinline__ unsigned cvt_pk_bf16(float lo, float hi) { f32x2 v = {lo, hi}; bf16x2_t b = __builtin_convertvector(v, bf16x2_t); return __builtin_bit_cast(unsigned, b); }
constexpr float RMS_EPS = 1e-6f;
constexpr float LOG2E = 1.4426950408889634f;
__device__ __forceinline__ float sum16(const float* p) { const f32x4 a = *(const f32x4*)p, b = *(const f32x4*)(p + 4), c = *(const f32x4*)(p + 8), d = *(const f32x4*)(p + 12);
    return ((a[0] + a[1]) + (a[2] + a[3])) + ((b[0] + b[1]) + (b[2] + b[3])) + ((c[0] + c[1]) + (c[2] + c[3])) + ((d[0] + d[1]) + (d[2] + d[3])); }
__device__ __forceinline__ float sum4(const float* p) { const f32x4 a = *(const f32x4*)p; return (a[0] + a[1]) + (a[2] + a[3]); }
__device__ __forceinline__ float dot4(const f32x4 a) { return (a[0] * a[0] + a[1] * a[1]) + (a[2] * a[2] + a[3] * a[3]); }
__device__ __forceinline__ void rope4(f32x4& x1, f32x4& x2, const f32x4 c, const f32x4 s) { const f32x4 a = x1 * c - x2 * s, b = x2 * c + x1 * s; x1 = a; x2 = b; }

struct EpiUp {
    static constexpr bool PERM = true, AFTER_DRAIN = false;
    bf16_t* H; const PG8_LAS float* rst; int ldh;
    __device__ __forceinline__ void operator()(const f32x4 (&acc)[2][2][4][2], const Unit& u, int wr, int wc, int fr, int fq) const {
        const int rl0 = wr * 64 + fr, row0 = u.pm * BM + rl0, col0 = u.pn * HALF + wc * 32 + 8 * fq;
        const PG8_LAS float* rt = rst + u.ord * BM + rl0;
#pragma unroll
        for (int ai = 0; ai < 2; ++ai)
#pragma unroll
            for (int m = 0; m < 4; ++m) { const int row = row0 + ai * HALF + m * 16;
                const float rs = rt[ai * HALF + m * 16], rs2 = rs * rs, c1 = -rs * LOG2E;
                float hv[8];
#pragma unroll
                for (int n = 0; n < 2; ++n)
#pragma unroll
                    for (int e = 0; e < 4; ++e) { const float ag = acc[ai][0][m][n][e], au = acc[ai][1][m][n][e];
                        hv[n * 4 + e] = (ag * au) * (rs2 * __builtin_amdgcn_rcpf(1.0f + __builtin_amdgcn_exp2f(ag * c1))); }
                u32x4 w; w.x = cvt_pk_bf16(hv[0], hv[1]); w.y = cvt_pk_bf16(hv[2], hv[3]); w.z = cvt_pk_bf16(hv[4], hv[5]); w.w = cvt_pk_bf16(hv[6], hv[7]);
                *(u32x4*)(H + (size_t)row * ldh + col0) = w; }
    }
};
__device__ __forceinline__ float bf_lo(unsigned w) { return __builtin_bit_cast(float, w << 16); }
__device__ __forceinline__ float bf_hi(unsigned w) { return __builtin_bit_cast(float, w & 0xffff0000u); }
struct EpiRes {
    static constexpr bool PERM = true, AFTER_DRAIN = false;
    bf16_t* xb; float* part; float s;
    __device__ __forceinline__ void operator()(const f32x4 (&acc)[2][2][4][2], const Unit& u, int wr, int wc, int fr, int fq) const {
        const int row0 = u.pm * BM + wr * 64 + fr, col0 = u.pn * BM + wc * 32 + 8 * fq;
#pragma unroll
        for (int ai = 0; ai < 2; ++ai) {
            u32x4 pre[4][2];
#pragma unroll
            for (int m = 0; m < 4; ++m) { const size_t off = (size_t)(row0 + ai * HALF + m * 16) * 1024 + col0;
#pragma unroll
                for (int bj = 0; bj < 2; ++bj) pre[m][bj] = *(const u32x4*)(xb + off + bj * HALF); }
#pragma unroll
            for (int m = 0; m < 4; ++m) { const int row = row0 + ai * HALF + m * 16; const size_t off = (size_t)row * 1024 + col0; float ss = 0.f;
#pragma unroll
                for (int bj = 0; bj < 2; ++bj) { const u32x4 b = pre[m][bj];
                    const f32x4 v0 = (f32x4){bf_lo(b.x), bf_hi(b.x), bf_lo(b.y), bf_hi(b.y)} + acc[ai][bj][m][0] * s;
                    const f32x4 v1 = (f32x4){bf_lo(b.z), bf_hi(b.z), bf_lo(b.w), bf_hi(b.w)} + acc[ai][bj][m][1] * s;
                    u32x4 w; w.x = cvt_pk_bf16(v0[0], v0[1]); w.y = cvt_pk_bf16(v0[2], v0[3]); w.z = cvt_pk_bf16(v1[0], v1[1]); w.w = cvt_pk_bf16(v1[2], v1[3]);
                    *(u32x4*)(xb + off + bj * HALF) = w; ss += dot4(v0) + dot4(v1); }
                ss += SWZ_XOR(ss, 16); ss = x32_sum(ss);
                if (fq == 0) part[(size_t)row * 16 + u.pn * 4 + wc] = ss; }
            asm volatile("" ::: "memory"); }
    }
};
struct EpiIn {
    static constexpr bool PERM = true, AFTER_DRAIN = false;
    bf16_t* P; const PG8_LAS float* rst; float* partq; float* partkv; const float* cosd; const float* sind; const float* cosm; const float* sinm; int ldp; float qscale;
    __device__ __forceinline__ void operator()(const f32x4 (&acc)[2][2][4][2], const Unit& u, int wr, int wc, int fr, int fq) const {
        const int tile = u.pn; const int rl0 = wr * 64 + fr, row0 = u.pm * BM + rl0, col0 = tile * BM + wc * 32 + 8 * fq;
        const PG8_LAS float* rt = rst + u.ord * BM + rl0;
        const float cs = (tile < 2 || tile == 8) ? qscale : 1.0f;
        const bool ropeD = (tile < 4) && ((wc & 1) == 0) && (fq < 2);
        const bool ropeM = (tile == 7) && (wc == 0);
        const float* ct = ropeD ? cosd : cosm; const float* sn = ropeD ? sind : sinm; const int sh = ropeD ? 3 : 4;
#pragma unroll
        for (int ai = 0; ai < 2; ++ai) {
            f32x4 rc[4], rsn[4];
            if (ropeD || ropeM) {
#pragma unroll
                for (int m = 0; m < 4; ++m) { const int pos = (row0 + ai * HALF + m * 16) & 4095; rc[m] = *(const f32x4*)(ct + (pos << sh) + 4 * fq); rsn[m] = *(const f32x4*)(sn + (pos << sh) + 4 * fq); } }
#pragma unroll
            for (int m = 0; m < 4; ++m) { const int row = row0 + ai * HALF + m * 16;
                const float rs = cs * rt[ai * HALF + m * 16];
                f32x4 v[2][2];
#pragma unroll
                for (int bj = 0; bj < 2; ++bj)
#pragma unroll
                    for (int n = 0; n < 2; ++n) v[bj][n] = acc[ai][bj][m][n] * rs;
                if (ropeD) { rope4(v[0][0], v[0][1], rc[m], rsn[m]); rope4(v[1][0], v[1][1], rc[m], rsn[m]); }
                if (ropeM) { rope4(v[1][0], v[1][1], rc[m], rsn[m]); }
                if (tile == 6) { float ss = (dot4(v[0][0]) + dot4(v[0][1])) + (dot4(v[1][0]) + dot4(v[1][1])); ss += SWZ_XOR(ss, 16); ss = x32_sum(ss); if (fq == 0) partq[(size_t)row * 4 + wc] = ss; }
                if (tile == 7) { float ss = dot4(v[0][0]) + dot4(v[0][1]); ss += SWZ_XOR(ss, 16); ss = x32_sum(ss); if (fq == 0) partkv[(size_t)row * 4 + wc] = ss; }
#pragma unroll
                for (int bj = 0; bj < 2; ++bj) { u32x4 w; w.x = cvt_pk_bf16(v[bj][0][0], v[bj][0][1]); w.y = cvt_pk_bf16(v[bj][0][2], v[bj][0][3]); w.z = cvt_pk_bf16(v[bj][1][0], v[bj][1][1]); w.w = cvt_pk_bf16(v[bj][1][2], v[bj][1][3]);
                    *(u32x4*)(P + (size_t)row * ldp + col0 + bj * HALF) = w; }
                asm volatile("" ::: "memory"); } }
    }
};
template <bool ROPE> struct EpiMla {
    static constexpr bool PERM = true, AFTER_DRAIN = false;
    bf16_t* O; const PG8_LAS float* rst; const float* cosm; const float* sinm; int ldo;
    __device__ __forceinline__ void operator()(const f32x4 (&acc)[2][2][4][2], const Unit& u, int wr, int wc, int fr, int fq) const {
        const int rl0 = wr * 64 + fr, row0 = u.pm * BM + rl0, col0 = u.pn * BM + wc * 32 + 8 * fq;
        const PG8_LAS float* rt = rst + u.ord * BM + rl0;
#pragma unroll
        for (int ai = 0; ai < 2; ++ai)
#pragma unroll
            for (int m = 0; m < 4; ++m) { const int row = row0 + ai * HALF + m * 16; const int pos = row & 4095;
                const float rs = rt[ai * HALF + m * 16];
                f32x4 v[2][2];
#pragma unroll
                for (int bj = 0; bj < 2; ++bj)
#pragma unroll
                    for (int n = 0; n < 2; ++n) v[bj][n] = acc[ai][bj][m][n] * rs;
                if (ROPE && wc == 2) { const f32x4 c = *(const f32x4*)(cosm + pos * 16 + 4 * fq), s = *(const f32x4*)(sinm + pos * 16 + 4 * fq); rope4(v[0][0], v[0][1], c, s); rope4(v[1][0], v[1][1], c, s); }
#pragma unroll
                for (int bj = 0; bj < 2; ++bj) { u32x4 w; w.x = cvt_pk_bf16(v[bj][0][0], v[bj][0][1]); w.y = cvt_pk_bf16(v[bj][0][2], v[bj][0][3]); w.z = cvt_pk_bf16(v[bj][1][0], v[bj][1][1]); w.w = cvt_pk_bf16(v[bj][1][2], v[bj][1][3]);
                    *(u32x4*)(O + (size_t)row * ldo + col0 + bj * HALF) = w; }
                asm volatile("" ::: "memory"); }
    }
};

template <int NP, class Sched>
__device__ __forceinline__ void fill_rowscale(PG8_LAS float* tab, const Sched& S, const float* parts, float inv_n, float scale, int tid) {
    Unit u; int nu = 0; while (S.next(nu, u)) ++nu;
    constexpr bool WIDE = (NP == 16);
    const int r0 = WIDE ? (tid >> 2) : (tid & 255), q = WIDE ? (tid & 3) : 0;
    const bool on = WIDE || tid < 256;
    f32x4 c0 = {0.f, 0.f, 0.f, 0.f}, c1 = c0, n0 = c0, n1 = c0;
    if (nu > 0 && on) { S.next(0, u); const float* p = parts + ((size_t)u.pm * BM + r0) * NP + q * 4; c0 = *(const f32x4*)p; if (WIDE) c1 = *(const f32x4*)(p + 128 * NP); }
    for (int i = 0; i < nu; ++i) {
        if (i + 1 < nu && on) { S.next(i + 1, u); const float* p = parts + ((size_t)u.pm * BM + r0) * NP + q * 4; n0 = *(const f32x4*)p; if (WIDE) n1 = *(const f32x4*)(p + 128 * NP); }
        float s0 = (c0[0] + c0[1]) + (c0[2] + c0[3]), s1 = (c1[0] + c1[1]) + (c1[2] + c1[3]);
        if (WIDE) { s0 += SWZ_XOR(s0, 1); s0 += SWZ_XOR(s0, 2); s1 += SWZ_XOR(s1, 1); s1 += SWZ_XOR(s1, 2); }
        if (on && q == 0) { tab[i * BM + r0] = scale / sqrtf(s0 * inv_n + RMS_EPS); if (WIDE) tab[i * BM + 128 + r0] = scale / sqrtf(s1 * inv_n + RMS_EPS); }
        c0 = n0; c1 = n1;
    }
    asm volatile("s_waitcnt lgkmcnt(0)" ::: "memory"); __builtin_amdgcn_s_barrier(); asm volatile("" ::: "memory");
}
template <class Epi, class Sched, bool ALIGN_EPI = false, bool SP2 = false>
__device__ __forceinline__ void gemm_phase(PG8_LAS unsigned char* lds, const Gemm g, const Sched& S, const Epi& E, int wave_in  ) {
    unsigned m_ = ~0u; asm volatile("" : "+s"(m_), "+s"(wave_in)); const int tid_ = wave_in * 64 + (int)__builtin_amdgcn_mbcnt_hi(m_, __builtin_amdgcn_mbcnt_lo(m_, 0u));
    const int tid = tid_, wid = __builtin_amdgcn_readfirstlane(tid >> 6), lane = tid & 63, wr = wid >> 2, wc = wid & 3, fr = lane & 15, fq = lane >> 4;
    const int K = g.K, nt = K / BK;
    unsigned voffA[2], voffB[2];
#pragma unroll
    for (int i = 0; i < 2; ++i) { int R, C; stage_rc(tid * 16 + i * 8192, R, C); const int Rb = Epi::PERM ? ((R & ~31) + perm32(R & 31)) : R;
        voffA[i] = (unsigned)(R * g.lda + C) * 2u; voffB[i] = (unsigned)(Rb * g.ldb + C) * 2u; }
    const size_t kstep = (size_t)(BK * 2);
    const size_t hstepA = (size_t)HALF * g.lda * 2, hstepB = (size_t)HALF * g.ldb * 2;
    const size_t tstepA = 2 * hstepA, tstepB = 2 * hstepB;
    const unsigned ldsw = (unsigned)wid * 1024u;
    const int aoff = lds_byte(wr * 64 + fr, fq * 8), boff = lds_byte(wc * 32 + fr, fq * 8);
#define PG8_SA(b, h) (((b) * 2 + (h)) * HTB)
#define PG8_SB(b, h) ((4 + (b) * 2 + (h)) * HTB)
#define PG8_STAGE(bufoff, gbase, voff) do { _Pragma("unroll") for (int _i = 0; _i < 2; ++_i) \
        __builtin_amdgcn_global_load_lds((const unsigned*)((const char*)(gbase) + (voff)[_i]), (PG8_LAS unsigned*)(lds + (bufoff) + ldsw + _i * 8192), 16, 0, 0); } while (0)
#define PG8_LDA(dst, b, h) do { _Pragma("unroll") for (int m = 0; m < 4; ++m) _Pragma("unroll") for (int k = 0; k < 2; ++k) dst[m][k] = *(const PG8_LAS bf16x8*)(lds + PG8_SA(b, h) + aoff + m * 2048 + k * 1024); } while (0)
#define PG8_LDB(dst, b, h) do { _Pragma("unroll") for (int n = 0; n < 2; ++n) _Pragma("unroll") for (int k = 0; k < 2; ++k) dst[n][k] = *(const PG8_LAS bf16x8*)(lds + PG8_SB(b, h) + boff + n * 2048 + k * 1024); } while (0)
#define PG8_MMA(ai, bj, At, Bt) do { __builtin_amdgcn_s_setprio(1); _Pragma("unroll") for (int m = 0; m < 4; ++m) _Pragma("unroll") for (int n = 0; n < 2; ++n) _Pragma("unroll") for (int k = 0; k < 2; ++k) \
        acc[ai][bj][m][n] = __builtin_amdgcn_mfma_f32_16x16x32_bf16(Bt[n][k], At[m][k], acc[ai][bj][m][n], 0, 0, 0); __builtin_amdgcn_s_setprio(0); } while (0)
#define PG8_WAIT_V(n) asm volatile("s_waitcnt vmcnt(" #n ")" ::: "memory")
#define PG8_WAIT_L(n) asm volatile("s_waitcnt lgkmcnt(" #n ")" ::: "memory")
#define PG8_BAR __builtin_amdgcn_s_barrier()
#define PG8_SCHED __builtin_amdgcn_sched_barrier(0)
    Unit cur, nxt; int ui = 0;
    if (!S.next(0, cur)) return;
    f32x4 acc[2][2][4][2];
#pragma unroll
    for (int a = 0; a < 2; ++a)
#pragma unroll
        for (int b = 0; b < 2; ++b)
#pragma unroll
            for (int m = 0; m < 4; ++m)
#pragma unroll
                for (int n = 0; n < 2; ++n) acc[a][b][m][n] = (f32x4){0.f, 0.f, 0.f, 0.f};
    bf16x8 At[4][2], B0[2][2], B1[2][2];
    const char* cA = (const char*)g.A + (size_t)cur.pm * tstepA; const char* cB = (const char*)g.Bt + (size_t)cur.pn * tstepB;
    S.a_ready(cur);
    if constexpr (SP2) {
        PG8_STAGE(PG8_SB(0, 0), cB, voffB); PG8_STAGE(PG8_SB(0, 1), cB + hstepB, voffB); PG8_STAGE(PG8_SA(0, 0), cA, voffA); PG8_STAGE(PG8_SA(0, 1), cA + hstepA, voffA);
        if (wr == 1) PG8_BAR;
        PG8_WAIT_V(2); PG8_BAR;
        PG8_STAGE(PG8_SB(1, 0), cB + kstep, voffB); PG8_STAGE(PG8_SA(1, 0), cA + kstep, voffA); PG8_STAGE(PG8_SB(1, 1), cB + hstepB + kstep, voffB);
        PG8_WAIT_V(6); PG8_BAR;
    } else {
        PG8_STAGE(PG8_SB(0, 0), cB, voffB); PG8_STAGE(PG8_SA(0, 0), cA, voffA); PG8_STAGE(PG8_SB(0, 1), cB + hstepB, voffB); PG8_STAGE(PG8_SA(0, 1), cA + hstepA, voffA);
        if (wr == 1) PG8_BAR;
        PG8_WAIT_V(4); PG8_BAR;
        PG8_STAGE(PG8_SB(1, 0), cB + kstep, voffB); PG8_STAGE(PG8_SA(1, 0), cA + kstep, voffA); PG8_STAGE(PG8_SB(1, 1), cB + hstepB + kstep, voffB);
        PG8_WAIT_V(6); PG8_BAR;
    }
    for (;;) {
        const bool has_next = S.next(ui + 1, nxt);
        const char* nA = has_next ? (const char*)g.A + (size_t)nxt.pm * tstepA : cA; const char* nB = has_next ? (const char*)g.Bt + (size_t)nxt.pn * tstepB : cB;
        for (int t = 0; t < nt; t += 2) {
            const bool last = (t == nt - 2);
            const char* a1 = cA + (size_t)(t + 1) * kstep;
            const char* a2 = last ? nA : cA + (size_t)(t + 2) * kstep; const char* b2 = last ? nB : cB + (size_t)(t + 2) * kstep;
            const char* a3 = a2 + kstep; const char* b3 = b2 + kstep;
            if (last && has_next) S.a_ready(nxt);
            if constexpr (SP2) {
            PG8_LDB(B0, 0, 0); PG8_LDB(B1, 0, 1); PG8_SCHED; PG8_LDA(At, 0, 0); PG8_STAGE(PG8_SA(1, 1), a1 + hstepA, voffA);
            PG8_WAIT_V(8); PG8_WAIT_L(0); PG8_BAR; PG8_MMA(0, 0, At, B0); PG8_MMA(0, 1, At, B1); PG8_BAR; PG8_SCHED;
            PG8_LDA(At, 0, 1); PG8_STAGE(PG8_SB(0, 0), b2, voffB); PG8_STAGE(PG8_SB(0, 1), b2 + hstepB, voffB); PG8_STAGE(PG8_SA(0, 0), a2, voffA);
            PG8_WAIT_V(8); PG8_WAIT_L(0); PG8_BAR; PG8_MMA(1, 0, At, B0); PG8_MMA(1, 1, At, B1); PG8_BAR; PG8_SCHED;
            PG8_LDB(B0, 1, 0); PG8_LDB(B1, 1, 1); PG8_SCHED; PG8_LDA(At, 1, 0); PG8_STAGE(PG8_SA(0, 1), a2 + hstepA, voffA);
            PG8_WAIT_V(8); PG8_WAIT_L(0); PG8_BAR; PG8_MMA(0, 0, At, B0); PG8_MMA(0, 1, At, B1); PG8_BAR; PG8_SCHED;
            PG8_LDA(At, 1, 1); PG8_STAGE(PG8_SB(1, 0), b3, voffB); PG8_STAGE(PG8_SB(1, 1), b3 + hstepB, voffB); PG8_STAGE(PG8_SA(1, 0), a3, voffA);
            PG8_WAIT_V(8); PG8_WAIT_L(0); PG8_BAR; PG8_MMA(1, 0, At, B0); PG8_MMA(1, 1, At, B1); PG8_BAR; PG8_SCHED;
            } else {
            PG8_LDB(B0, 0, 0); PG8_SCHED; PG8_LDA(At, 0, 0); PG8_STAGE(PG8_SA(1, 1), a1 + hstepA, voffA);
            PG8_WAIT_L(8); PG8_BAR; PG8_WAIT_L(0); PG8_MMA(0, 0, At, B0); PG8_BAR; PG8_SCHED;
            PG8_LDB(B1, 0, 1); PG8_STAGE(PG8_SB(0, 0), b2, voffB);
            PG8_BAR; PG8_WAIT_L(0); PG8_MMA(0, 1, At, B1); PG8_BAR;
            PG8_LDA(At, 0, 1); PG8_STAGE(PG8_SA(0, 0), a2, voffA);
            PG8_BAR; PG8_WAIT_L(0); PG8_MMA(1, 0, At, B0); PG8_BAR; PG8_SCHED;
            PG8_STAGE(PG8_SB(0, 1), b2 + hstepB, voffB);
            PG8_WAIT_V(6); PG8_BAR; PG8_MMA(1, 1, At, B1); PG8_BAR;
            PG8_LDB(B0, 1, 0); PG8_SCHED; PG8_LDA(At, 1, 0); PG8_STAGE(PG8_SA(0, 1), a2 + hstepA, voffA);
            PG8_WAIT_L(8); PG8_BAR; PG8_WAIT_L(0); PG8_MMA(0, 0, At, B0); PG8_BAR; PG8_SCHED;
            PG8_LDB(B1, 1, 1); PG8_STAGE(PG8_SB(1, 0), b3, voffB);
            PG8_BAR; PG8_WAIT_L(0); PG8_MMA(0, 1, At, B1); PG8_BAR;
            PG8_LDA(At, 1, 1); PG8_STAGE(PG8_SA(1, 0), a3, voffA);
            PG8_BAR; PG8_WAIT_L(0); PG8_MMA(1, 0, At, B0); PG8_BAR; PG8_SCHED;
            PG8_STAGE(PG8_SB(1, 1), b3 + hstepB, voffB);
            PG8_WAIT_V(6); PG8_BAR; PG8_MMA(1, 1, At, B1); PG8_BAR;
            }
        }
        if constexpr (ALIGN_EPI) { if (wr == 0) PG8_BAR; }
        if constexpr (!Epi::AFTER_DRAIN) { unsigned m2_ = ~0u; asm volatile("" : "+s"(m2_)); const int ln_ = (int)__builtin_amdgcn_mbcnt_hi(m2_, __builtin_amdgcn_mbcnt_lo(m2_, 0u)); E(acc, cur, wr, wc, ln_ & 15, ln_ >> 4); S.done(cur); }
        if (!has_next) break;
#pragma unroll
        for (int a = 0; a < 2; ++a)
#pragma unroll
            for (int b = 0; b < 2; ++b)
#pragma unroll
                for (int m = 0; m < 4; ++m)
#pragma unroll
                    for (int n = 0; n < 2; ++n) acc[a][b][m][n] = (f32x4){0.f, 0.f, 0.f, 0.f};
        cur = nxt; cA = nA; cB = nB; ++ui;
        if constexpr (ALIGN_EPI) { if (wr == 1) PG8_BAR; }
    }
    PG8_WAIT_V(0);
    if constexpr (!ALIGN_EPI) { if (wr == 0) PG8_BAR; }
    PG8_BAR;
    if constexpr (Epi::AFTER_DRAIN) { E.fused(acc, cur, wr, wc, fr, fq, lds, wid, lane); S.done(cur); }
#undef PG8_SA
#undef PG8_SB
#undef PG8_STAGE
#undef PG8_LDA
#undef PG8_LDB
#undef PG8_MMA
#undef PG8_WAIT_V
#undef PG8_WAIT_L
#undef PG8_BAR
#undef PG8_SCHED
}
}
namespace att {
#define LAS3 __attribute__((address_space(3)))
typedef unsigned short bf16_t;
typedef short bf16x8 __attribute__((ext_vector_type(8)));
typedef short s16x4 __attribute__((ext_vector_type(4)));
typedef float f32x16 __attribute__((ext_vector_type(16)));
typedef float f32x4 __attribute__((ext_vector_type(4)));
typedef float f32x2_t __attribute__((ext_vector_type(2)));
typedef __bf16 bf16x2_t __attribute__((ext_vector_type(2)));
typedef unsigned u32x4 __attribute__((ext_vector_type(4)));
typedef unsigned u32x2 __attribute__((ext_vector_type(2)));
typedef short v4i16_t __attribute__((ext_vector_type(4)));
constexpr int SEQ = 4096;
constexpr int LDS_SBV = 0;
__device__ __forceinline__ unsigned cvtpk(float lo, float hi) { f32x2_t v = {lo, hi}; bf16x2_t b = __builtin_convertvector(v, bf16x2_t); return __builtin_bit_cast(unsigned, b); }
__device__ __forceinline__ s16x4 vtr(const LAS3 char* p) { return __builtin_bit_cast(s16x4, __builtin_amdgcn_ds_read_tr16_b64_v4i16((LAS3 v4i16_t*)p)); }
__device__ __forceinline__ void glds16(const void* gsrc, unsigned lds_dst) { unsigned keep;
    asm volatile("s_mov_b32 %0, m0\n\ts_mov_b32 m0, %2\n\ts_nop 0\n\tglobal_load_lds_dwordx4 %1, off\n\ts_mov_b32 m0, %0" : "=&s"(keep) : "v"(gsrc), "s"(lds_dst) : "memory"); }
__device__ __forceinline__ float ex2(float x) { return __builtin_amdgcn_exp2f(x); }
__device__ __forceinline__ float lg2(float x) { return __builtin_amdgcn_logf(x); }
#define ATT_MFMA(a, b, c) __builtin_amdgcn_mfma_f32_32x32x16_bf16((a), (b), (c), 0, 0, 0)
#define ATT_VFR(lo, hi) (bf16x8){lo[0], lo[1], lo[2], lo[3], hi[0], hi[1], hi[2], hi[3]}

template <int NQK>
__device__ __forceinline__ void sm_qk(f32x16& p0, f32x16& p1, const bf16x8 (&qf)[NQK], const LAS3 char* ks, const int (&ko)[NQK]) {
    constexpr int H = NQK / 2;
    bf16x8 kf[2][H][2];
#pragma unroll
    for (int j = 0; j < H; ++j) { kf[0][j][0] = *(const LAS3 bf16x8*)(ks + ko[j]); kf[0][j][1] = *(const LAS3 bf16x8*)(ks + ko[j] + (j < 4 ? 4096 : 2048)); }
    __builtin_amdgcn_sched_barrier(0);
#pragma unroll
    for (int j = 0; j < H; ++j) { kf[1][j][0] = *(const LAS3 bf16x8*)(ks + ko[H + j]); kf[1][j][1] = *(const LAS3 bf16x8*)(ks + ko[H + j] + ((H + j) < 4 ? 4096 : 2048)); }
    p0 = f32x16{}; p1 = f32x16{};
#pragma unroll
    for (int j = 0; j < H; ++j) { p0 = ATT_MFMA(kf[0][j][0], qf[j], p0); p1 = ATT_MFMA(kf[0][j][1], qf[j], p1); }
    __builtin_amdgcn_sched_barrier(0);
#pragma unroll
    for (int j = 0; j < H; ++j) { p0 = ATT_MFMA(kf[1][j][0], qf[H + j], p0); p1 = ATT_MFMA(kf[1][j][1], qf[H + j], p1); }
    __builtin_amdgcn_sched_barrier(0);
}
template <int NV>
__device__ __forceinline__ void sm_softmax_pv(f32x16 (&o)[NV], float& m_ref, float& l_run, f32x16& p0, f32x16& p1, const LAS3 char* vb) {
    s16x4 vl[2][NV], vh[2][NV];
#pragma unroll
    for (int d0 = 0; d0 < NV; ++d0) { vl[0][d0] = vtr(vb + d0 * 4096); vh[0][d0] = vtr(vb + d0 * 4096 + 512); }
    float mx = fmaxf(p0[0], p1[0]);
#pragma unroll
    for (int r = 1; r < 16; ++r) mx = fmaxf(fmaxf(mx, p0[r]), p1[r]);
    mx = x32_max(mx);
    if (__any(mx > m_ref + 8.0f)) {
        const float mn = fmaxf(m_ref, mx), alpha = ex2(m_ref - mn); m_ref = mn; l_run *= alpha;
#pragma unroll
        for (int d0 = 0; d0 < NV; ++d0)
#pragma unroll
            for (int r = 0; r < 16; ++r) o[d0][r] *= alpha;
    }
    float s = 0.f;
#pragma unroll
    for (int r = 0; r < 16; ++r) { p0[r] = ex2(p0[r] - m_ref); p1[r] = ex2(p1[r] - m_ref); s += p0[r] + p1[r]; }
    l_run += s;
    u32x4 pw[4];
#pragma unroll
    for (int i = 0; i < 4; ++i) { pw[0][i] = cvtpk(p0[2 * i], p0[2 * i + 1]); pw[1][i] = cvtpk(p0[8 + 2 * i], p0[9 + 2 * i]); pw[2][i] = cvtpk(p1[2 * i], p1[2 * i + 1]); pw[3][i] = cvtpk(p1[8 + 2 * i], p1[9 + 2 * i]); }
    __builtin_amdgcn_sched_barrier(0);
#pragma unroll
    for (int ks = 0; ks < 4; ++ks) {
        if (ks < 3) {
#pragma unroll
            for (int d0 = 0; d0 < NV; ++d0) { vl[(ks + 1) & 1][d0] = vtr(vb + d0 * 4096 + (ks + 1) * 1024); vh[(ks + 1) & 1][d0] = vtr(vb + d0 * 4096 + (ks + 1) * 1024 + 512); } }
#pragma unroll
        for (int d0 = 0; d0 < NV; ++d0) o[d0] = ATT_MFMA(ATT_VFR(vl[ks & 1][d0], vh[ks & 1][d0]), __builtin_bit_cast(bf16x8, pw[ks]), o[d0]);
        __builtin_amdgcn_sched_barrier(0); }
}

template <int NQK, int NV>
__device__ __forceinline__ void sm_pass(f32x16 (&o)[NV], const bf16x8 (&qf)[NQK], int nt_wg, int nt_wave, const bf16_t* k0p, int k0pitch, const bf16_t* k1p, int k1pitch,
                                        const bf16_t* vp, int vpitch, LAS3 char* lds, int wave, int lane) {
    static_assert((NQK == 4 && NV == 4) || (NQK == 6 && NV == 2), "3 DMA instructions per wave per tile");
    constexpr int NKW = (NQK == 4) ? 1 : 2, NVW = NV / 2;
    constexpr int KSLOT = 12288, VSLOT = 16384, VBASE = 3 * KSLOT;
    const int r32 = lane & 31, hi = lane >> 5;
    const LAS3 char* kp = lds;
    const unsigned lds0 = (unsigned)(unsigned long)lds;
    int ko[NQK];
#pragma unroll
    for (int j = 0; j < NQK; ++j) ko[j] = (j < 4) ? r32 * 128 + (((2 * j + hi) ^ ((r32 >> 1) & 7)) * 16) : 8192 + r32 * 64 + (((2 * (j - 4) + hi) ^ ((r32 >> 2) & 3)) * 16);
    const LAS3 char* vb = lds + VBASE + ((lane >> 4) & 1) * 32 + (lane & 3) * 8 + (4 * hi + ((lane & 15) >> 2)) * 64;
    float m_ref = -1e30f, l_run = 0.f;
#pragma unroll
    for (int d0 = 0; d0 < NV; ++d0) o[d0] = f32x16{};
    const int krow0 = 8 * wave + (lane >> 3), krow1 = 16 * (wave & 3) + (lane >> 2);
    const int koff0 = (krow0 * k0pitch + (((lane & 7) ^ ((krow0 >> 1) & 7)) * 8)) * 2, koff1 = (krow1 * k1pitch + (((lane & 3) ^ ((krow1 >> 2) & 3)) * 8)) * 2;
    const int voffl = ((lane >> 2) * vpitch + (lane & 3) * 8) * 2;
#define ATT_DMA_K(t, slot) do { \
        glds16((const char*)k0p + (size_t)(t) * 64 * k0pitch * 2 + koff0, (unsigned)__builtin_amdgcn_readfirstlane((int)(lds0 + (slot) * KSLOT + wave * 1024))); \
        if (NQK == 6) glds16((const char*)k1p + (size_t)(t) * 64 * k1pitch * 2 + koff1, (unsigned)__builtin_amdgcn_readfirstlane((int)(lds0 + (slot) * KSLOT + 8192 + (wave & 3) * 1024))); } while (0)
#define ATT_DMA_V(t, slot) do { _Pragma("unroll") for (int i = 0; i < NVW; ++i) { const int ch = wave + 8 * i; \
        const char* src = (const char*)vp + ((size_t)((t) * 64 + (ch & 3) * 16) * vpitch + (ch >> 2) * 32) * 2 + voffl; \
        glds16(src, (unsigned)__builtin_amdgcn_readfirstlane((int)(lds0 + VBASE + (slot) * VSLOT + ch * 1024))); } } while (0)
#define ATT_WAITBAR(N) asm volatile("s_waitcnt vmcnt(" #N ") lgkmcnt(0)\n\ts_barrier" ::: "memory")
    f32x16 a0, a1, b0, b1;
    ATT_WAITBAR(0);
    ATT_DMA_K(0, 0); ATT_DMA_V(0, 0); ATT_DMA_K(1, 1); ATT_DMA_V(1, 1); ATT_DMA_K(2, 2);
    ATT_WAITBAR(3);
    sm_qk<NQK>(a0, a1, qf, kp, ko);
    int s0 = 0, s1 = 1, s2 = 2;
#define ATT_STEP(tt, C0, C1, N0, N1, QKFIRST) do { \
        if ((tt) + 2 < nt_wg) ATT_WAITBAR(3); else ATT_WAITBAR(0); \
        if ((tt) + 3 < nt_wg) ATT_DMA_K((tt) + 3, s0); \
        if ((tt) + 2 < nt_wg) ATT_DMA_V((tt) + 2, s2); \
        if (QKFIRST) { sm_qk<NQK>(N0, N1, qf, kp + s1 * KSLOT, ko); if ((tt) < nt_wave) sm_softmax_pv<NV>(o, m_ref, l_run, C0, C1, vb + s0 * VSLOT); } \
        else { if ((tt) < nt_wave) sm_softmax_pv<NV>(o, m_ref, l_run, C0, C1, vb + s0 * VSLOT); sm_qk<NQK>(N0, N1, qf, kp + s1 * KSLOT, ko); } \
        { const int s_ = s0; s0 = s1; s1 = s2; s2 = s_; } } while (0)
    if (wave < 4) { for (int t = 0; t < nt_wg; t += 2) { ATT_STEP(t, a0, a1, b0, b1, true); ATT_STEP(t + 1, b0, b1, a0, a1, true); } }
    else          { for (int t = 0; t < nt_wg; t += 2) { ATT_STEP(t, a0, a1, b0, b1, false); ATT_STEP(t + 1, b0, b1, a0, a1, false); } }
#undef ATT_STEP
#undef ATT_DMA_K
#undef ATT_DMA_V
#undef ATT_WAITBAR
    const float l = x32_sum(l_run), inv = 1.0f / l;
#pragma unroll
    for (int d0 = 0; d0 < NV; ++d0)
#pragma unroll
        for (int r = 0; r < 16; ++r) o[d0][r] *= inv;
}

template <int NV, class Pack>
__device__ __forceinline__ void store_rows_staged(bf16_t* dst  , int ldd, LAS3 char* stg, int lane, const Pack& pack) {
    constexpr int ND = 32 * NV, PITCH = 2 * ND + 16, PPR = ND / 8;
    const int r32 = lane & 31, hi = lane >> 5;
#pragma unroll
    for (int d0 = 0; d0 < NV; ++d0)
#pragma unroll
        for (int r4 = 0; r4 < 4; ++r4) *(LAS3 u32x2*)(stg + r32 * PITCH + (32 * d0 + 8 * r4 + 4 * hi) * 2) = pack(d0, r4);
    asm volatile("s_waitcnt lgkmcnt(0)" ::: "memory");
#pragma unroll
    for (int it = 0; it < (32 * PPR) / 64; ++it) { const int idx = it * 64 + lane, row = idx / PPR, c = idx % PPR;
        const u32x4 v = *(const LAS3 u32x4*)(stg + row * PITCH + c * 16); *(u32x4*)(dst + (size_t)row * ldd + c * 8) = v; }
}
__device__ __forceinline__ void diff_unit(int b, int h, int qb, const bf16_t* P, int ldp, bf16_t* MG, const float* subln, float lam, float one_m_li, f32x4* stash  , LAS3 char* lds, int tid, int lane, int w) {
    const int r32 = lane & 31, hi = lane >> 5;
    const size_t row = (size_t)b * SEQ + qb * 256 + w * 32 + r32;
    const bf16_t* Pb = P + (size_t)b * SEQ * ldp;
    const int nt_wg = 4 * qb + 4, nt_wave = 4 * qb + (w >> 1) + 1;
    bf16x8 qf[4]; f32x16 o1[4];
#pragma unroll
    for (int j = 0; j < 4; ++j) qf[j] = *(const bf16x8*)(P + row * ldp + h * 128 + 16 * j + 8 * hi);
    sm_pass<4, 4>(o1, qf, nt_wg, nt_wave, Pb + 512 + h * 128, ldp, Pb, ldp, Pb + 1024 + h * 128, ldp, lds, w, lane);
#pragma unroll
    for (int d0 = 0; d0 < 4; ++d0)
#pragma unroll
        for (int r4 = 0; r4 < 4; ++r4) stash[(d0 * 4 + r4) * 64] = (f32x4){o1[d0][4 * r4], o1[d0][4 * r4 + 1], o1[d0][4 * r4 + 2], o1[d0][4 * r4 + 3]};
#pragma unroll
    for (int j = 0; j < 4; ++j) qf[j] = *(const bf16x8*)(P + row * ldp + h * 128 + 64 + 16 * j + 8 * hi);
    sm_pass<4, 4>(o1, qf, nt_wg, nt_wave, Pb + 512 + h * 128 + 64, ldp, Pb, ldp, Pb + 1024 + h * 128, ldp, lds, w, lane);
    float ss = 0.f;
#pragma unroll
    for (int d0 = 0; d0 < 4; ++d0)
#pragma unroll
        for (int r4 = 0; r4 < 4; ++r4) { const f32x4 a1 = stash[(d0 * 4 + r4) * 64];
#pragma unroll
            for (int e = 0; e < 4; ++e) { const float y = a1[e] - lam * o1[d0][4 * r4 + e]; o1[d0][4 * r4 + e] = y; ss += y * y; } }
    ss = x32_sum(ss);
    const float rn = one_m_li / sqrtf(ss * (1.0f / 128.0f) + 1e-6f);
    asm volatile("s_waitcnt lgkmcnt(0)\n\ts_barrier" ::: "memory");
    store_rows_staged<4>(MG + (row - r32) * 1024 + h * 128, 1024, lds + w * 8704, lane, [&](int d0, int r4) { const int d = 32 * d0 + 8 * r4 + 4 * hi; const f32x4 g = *(const f32x4*)(subln + d);
        u32x2 wv; wv.x = cvtpk(o1[d0][4 * r4] * rn * g[0], o1[d0][4 * r4 + 1] * rn * g[1]); wv.y = cvtpk(o1[d0][4 * r4 + 2] * rn * g[2], o1[d0][4 * r4 + 3] * rn * g[3]); return wv; });
}
__device__ __forceinline__ void mla_unit(int b, int h, int qb, const bf16_t* P, int ldp, const bf16_t* QB, const bf16_t* KV, bf16_t* MG, LAS3 char* lds, int tid, int lane, int w) {
    const int r32 = lane & 31, hi = lane >> 5;
    const size_t row = (size_t)b * SEQ + qb * 256 + w * 32 + r32;
    const bf16_t* Pb = P + (size_t)b * SEQ * ldp; const bf16_t* KVb = KV + (size_t)b * SEQ * 512;
    const int nt_wg = 4 * qb + 4, nt_wave = 4 * qb + (w >> 1) + 1;
    bf16x8 qf[6]; f32x16 o[2];
#pragma unroll
    for (int j = 0; j < 6; ++j) qf[j] = *(const bf16x8*)(QB + row * 512 + h * 128 + 16 * j + 8 * hi);
    sm_pass<6, 2>(o, qf, nt_wg, nt_wave, KVb + h * 128, 512, Pb + 1920, ldp, KVb + h * 128 + 64, 512, lds, w, lane);
    asm volatile("s_waitcnt lgkmcnt(0)\n\ts_barrier" ::: "memory");
    store_rows_staged<2>(MG + (row - r32) * 1024 + 512 + h * 64, 1024, lds + w * 4608, lane, [&](int d0, int r4) {
        u32x2 wv; wv.x = cvtpk(o[d0][4 * r4], o[d0][4 * r4 + 1]); wv.y = cvtpk(o[d0][4 * r4 + 2], o[d0][4 * r4 + 3]); return wv; });
}
constexpr float SB_STOP = 152.0f;
__device__ __forceinline__ void sb_unit(int b, int h, int qb32, const bf16_t* P, int ldp, bf16_t* MG, LAS3 char* vl, int lane) {
    const int r32 = lane & 31, hi = lane >> 5;
    const size_t row = (size_t)b * SEQ + qb32 * 32 + r32;
    const bf16_t* Pb = P + (size_t)b * SEQ * ldp;
    const int T = qb32 >> 1, qrel = (qb32 & 1) * 32 + r32;
    bf16x8 qf[4]; f32x16 o[2]; o[0] = f32x16{}; o[1] = f32x16{};
#pragma unroll
    for (int j = 0; j < 4; ++j) qf[j] = *(const bf16x8*)(P + row * ldp + 2048 + h * 64 + 16 * j + 8 * hi);
    const LAS3 char* vb = vl + ((lane >> 4) & 1) * 32 + (lane & 3) * 8 + (4 * hi + ((lane & 15) >> 2)) * 64;
    float R = 0.f;
    const int voffs = ((lane >> 3) * ldp + 2560 + h * 64 + (lane & 7) * 8) * 2;
    const int koffs = (r32 * ldp + 2304 + h * 64 + 8 * hi) * 2;
    u32x4 vr[8]; bf16x8 kf[4][2];
#define SB_FETCH(tt) do { const char* kt_ = (const char*)(Pb + (size_t)((tt) * 64) * ldp); \
        _Pragma("unroll") for (int it = 0; it < 8; ++it) vr[it] = *(const u32x4*)(kt_ + (size_t)(8 * it) * ldp * 2 + voffs); \
        _Pragma("unroll") for (int j = 0; j < 4; ++j) { kf[j][0] = *(const bf16x8*)(kt_ + koffs + 32 * j); kf[j][1] = *(const bf16x8*)(kt_ + (size_t)32 * ldp * 2 + koffs + 32 * j); } } while (0)
    SB_FETCH(T);
    for (int t = T; t >= 0; --t) {
        f32x16 p0 = {}, p1 = {};
#pragma unroll
        for (int j = 0; j < 4; ++j) { p0 = ATT_MFMA(kf[j][0], qf[j], p0); p1 = ATT_MFMA(kf[j][1], qf[j], p1); }
        asm volatile("s_waitcnt lgkmcnt(0)" ::: "memory");
#pragma unroll
        for (int it = 0; it < 8; ++it) { const int idx = it * 64 + lane, key = idx >> 3, c8 = idx & 7; *(LAS3 u32x4*)(vl + (c8 >> 2) * 4096 + key * 64 + (c8 & 3) * 16) = vr[it]; }
        if (t > 0) SB_FETCH(t - 1);
        const bool diag = (t == T);
        f32x16 s0, s1;
#pragma unroll
        for (int r = 0; r < 16; ++r) { const int kk = (r & 3) + 8 * (r >> 2) + 4 * hi;
            const float z0 = p0[r], z1 = p1[r];
            float a0 = fmaxf(z0, 0.f) + lg2(1.0f + ex2(-fabsf(z0))), a1 = fmaxf(z1, 0.f) + lg2(1.0f + ex2(-fabsf(z1)));
            if (diag && !(kk < qrel)) a0 = 0.f;
            if (diag && !(kk + 32 < qrel)) a1 = 0.f;
            s0[r] = a0; s1[r] = a1; }
        float own[8], oth[8];
#pragma unroll
        for (int i = 0; i < 4; ++i) { own[i] = (s0[4 * i] + s0[4 * i + 1]) + (s0[4 * i + 2] + s0[4 * i + 3]); own[4 + i] = (s1[4 * i] + s1[4 * i + 1]) + (s1[4 * i + 2] + s1[4 * i + 3]); }
#pragma unroll
        for (int i = 0; i < 8; ++i) oth[i] = x32_other(own[i], hi);
        float Aown[8]; float run = 0.f;
#pragma unroll
        for (int i = 7; i >= 0; --i) { const float Se = hi ? oth[i] : own[i], So = hi ? own[i] : oth[i];
            const float A_odd = run; run += So; const float A_even = run; run += Se;
            Aown[i] = hi ? A_odd : A_even; }
        const float tile_sum = run;
#pragma unroll
        for (int i = 0; i < 4; ++i) {
            float af0 = Aown[i] + R, af1 = Aown[4 + i] + R;
#pragma unroll
            for (int e = 3; e >= 0; --e) { const int r = 4 * i + e; const int kk = e + 8 * i + 4 * hi;
                const float sp0 = s0[r], sp1 = s1[r];
                float w0 = ex2(p0[r] - sp0 - af0), w1 = ex2(p1[r] - sp1 - af1);
                if (diag && !(kk < qrel)) w0 = 0.f;
                if (diag && !(kk + 32 < qrel)) w1 = 0.f;
                af0 += sp0; af1 += sp1; p0[r] = w0; p1[r] = w1; } }
        R += tile_sum;
        u32x4 pw[4];
#pragma unroll
        for (int i = 0; i < 4; ++i) { pw[0][i] = cvtpk(p0[2 * i], p0[2 * i + 1]); pw[1][i] = cvtpk(p0[8 + 2 * i], p0[9 + 2 * i]); pw[2][i] = cvtpk(p1[2 * i], p1[2 * i + 1]); pw[3][i] = cvtpk(p1[8 + 2 * i], p1[9 + 2 * i]); }
        asm volatile("s_waitcnt lgkmcnt(0)" ::: "memory");
#pragma unroll
        for (int d0 = 0; d0 < 2; ++d0)
#pragma unroll
            for (int ks = 0; ks < 4; ++ks) { const s16x4 lo = vtr(vb + d0 * 4096 + ks * 1024), hi4 = vtr(vb + d0 * 4096 + ks * 1024 + 512);
                o[d0] = ATT_MFMA(ATT_VFR(lo, hi4), __builtin_bit_cast(bf16x8, pw[ks]), o[d0]); }
        if (__all(R >= SB_STOP)) break;
    }
#undef SB_FETCH
    asm volatile("s_waitcnt lgkmcnt(0)" ::: "memory");
    store_rows_staged<2>(MG + (row - r32) * 1024 + 768 + h * 64, 1024, vl, lane, [&](int d0, int r4) {
        u32x2 wv; wv.x = cvtpk(o[d0][4 * r4], o[d0][4 * r4 + 1]); wv.y = cvtpk(o[d0][4 * r4 + 2], o[d0][4 * r4 + 3]); return wv; });
}
}
#define LAS __attribute__((address_space(3)))
typedef unsigned short bf16;
typedef unsigned v4u __attribute__((ext_vector_type(4)));
typedef float f32x4 __attribute__((ext_vector_type(4)));
constexpr int NWAVES = 8;
constexpr int BATCH = 8, SEQ = 4096, D = 1024, M = BATCH * SEQ, DFF = 2816, DEPTH = 2;
constexpr int NIN = 2816  , IN_SRC = 2720;
constexpr size_t MiB = 1u << 20;
constexpr size_t WS_COSD = 1 * MiB, WS_SIND = WS_COSD + 128 * 1024, WS_COSM = WS_SIND + 128 * 1024, WS_SINM = WS_COSM + 256 * 1024;
constexpr size_t WS_PART = 2 * MiB;
constexpr size_t WS_PARTQ = 4 * MiB;
constexpr size_t WS_PARTKV = 4 * MiB + 512 * 1024;
constexpr size_t WS_W = 8 * MiB, WS_WL = 42 * MiB;
constexpr size_t W_GU1 = 0, W_D1 = 11 * MiB, W_IN = W_D1 + 5632 * 1024, W_UQ = W_IN + 5632 * 1024, W_UKV = W_UQ + 256 * 1024, W_OUT = W_UKV + 256 * 1024, W_GU2 = W_OUT + 2 * MiB, W_D2 = W_GU2 + 11 * MiB;
static_assert(W_D2 + 5632 * 1024 <= WS_WL, "weight map");
constexpr size_t WS_XB = 96 * MiB;
constexpr size_t WS_MG = 160 * MiB;
constexpr size_t WS_QB = 224 * MiB;
constexpr size_t WS_KV = 256 * MiB;
constexpr size_t WS_HP = 288 * MiB;
constexpr size_t WS_STASH = 464 * MiB;
constexpr size_t WS_END = 496 * MiB;
constexpr int RING_BYTES = 131072, LDS_BYTES = 147456;

__device__ __forceinline__ unsigned f2bf(float f) { unsigned u = __builtin_bit_cast(unsigned, f); return (u + 0x7fffu + ((u >> 16) & 1u)) >> 16; }
__device__ __forceinline__ unsigned pk2(float lo, float hi) { return f2bf(lo) | (f2bf(hi) << 16); }
__device__ __forceinline__ int ropeperm(int p, int half) { return ((p >> 2) & 1) * half + 4 * (p >> 3) + (p & 3); }
__device__ __forceinline__ int src_col(int kind, int n, int nsrc, int& mat) {
    mat = 0;
    if (kind == 0) return n < nsrc ? n : -1;
    if (kind == 1) { const int pn = n >> 8, w = n & 255; mat = w >> 7; return pn * 128 + (w & 127); }
    if (kind == 2) { const int tile = n >> 8, w = n & 255;
        if (tile < 4) { const int d = n & 63; return d < 16 ? (n & ~63) + ropeperm(d, 8) : n; }
        if (tile < 7) return n;
        if (tile == 7) { if (w < 128) return 1792 + w; if (w < 160) return 1920 + ropeperm(w - 128, 16); return -1; }
        return n - 96; }
    { const int head = n >> 7, w = n & 127; if (w < 64) return head * 96 + w; if (w < 96) return head * 96 + 64 + ropeperm(w - 64, 16); return -1; }
}
__device__ __forceinline__ void wt_item(const float* W0, const float* W1, const float* gain, bf16* WT, int Ksrc, int Kdst, int Nsrc, int Ndst, int kind, LAS float* scr  , int item, int lane) {
    const int nblk = Ndst / 64, kb = item / nblk, nb = item % nblk, k0 = 64 * kb, n0 = 64 * nb;
    int mat; const int sc = src_col(kind, n0 + lane, Nsrc, mat); const float* W = mat ? W1 : W0;
    const bool live = (sc >= 0) && (k0 < Ksrc);
    const float* wp = W + (size_t)k0 * Nsrc + (live ? sc : 0);
#pragma unroll 16
    for (int kk = 0; kk < 64; ++kk) { float v = 0.f; if (live) v = wp[(size_t)kk * Nsrc]; scr[kk * 65 + lane] = v; }
    asm volatile("s_waitcnt lgkmcnt(0)" ::: "memory");
    const int c = lane & 7;
    f32x4 g0 = {1.f, 1.f, 1.f, 1.f}, g1 = {1.f, 1.f, 1.f, 1.f};
    if (gain && k0 < Ksrc) { g0 = *(const f32x4*)(gain + k0 + 8 * c); g1 = *(const f32x4*)(gain + k0 + 8 * c + 4); }
#pragma unroll
    for (int j = 0; j < 8; ++j) { const int n = (lane >> 3) + 8 * j; const LAS float* s = scr + (8 * c) * 65 + n;
        v4u o; o.x = pk2(s[0 * 65] * g0[0], s[1 * 65] * g0[1]); o.y = pk2(s[2 * 65] * g0[2], s[3 * 65] * g0[3]); o.z = pk2(s[4 * 65] * g1[0], s[5 * 65] * g1[1]); o.w = pk2(s[6 * 65] * g1[2], s[7 * 65] * g1[3]);
        *(v4u*)(WT + (size_t)(n0 + n) * Kdst + k0 + 8 * c) = o; }
    asm volatile("s_waitcnt lgkmcnt(0)" ::: "memory");
}
__device__ __forceinline__ void wt_tile(const float* W0, const float* W1, const float* gain, bf16* WT, int Ksrc, int Kdst, int Nsrc, int Ndst, int kind, LAS float* img, int tile, int wave, int lane) {
    constexpr int S = 260;
    const int nblk = Ndst / 256, kb = tile / nblk, nb = tile % nblk, k0 = 128 * kb, n0 = 256 * nb;
    int mat; const int sc = src_col(kind, n0 + 4 * lane, Nsrc, mat); const float* W = mat ? W1 : W0;
    const bool live = (sc >= 0) && (k0 < Ksrc);
    const float* wp = W + (size_t)(k0 + wave) * Nsrc + (live ? sc : 0);
    f32x4 v[16];
#pragma unroll
    for (int i = 0; i < 16; ++i) v[i] = live ? *(const f32x4*)(wp + (size_t)(8 * i) * Nsrc) : (f32x4){0.f, 0.f, 0.f, 0.f};
#pragma unroll
    for (int i = 0; i < 16; ++i) { const int kl = wave + 8 * i; const float g = (gain && k0 < Ksrc) ? gain[k0 + kl] : 1.0f; *(LAS f32x4*)(img + kl * S + 4 * lane) = v[i] * g; }
    __syncthreads();
    const int c = lane & 15, nsub = lane >> 4;
#pragma unroll
    for (int j = 0; j < 8; ++j) { const int n = 32 * j + 4 * wave + nsub; const LAS float* s = img + (8 * c) * S + n;
        v4u o; o.x = pk2(s[0 * S], s[1 * S]); o.y = pk2(s[2 * S], s[3 * S]); o.z = pk2(s[4 * S], s[5 * S]); o.w = pk2(s[6 * S], s[7 * S]);
        *(v4u*)(WT + (size_t)(n0 + n) * Kdst + k0 + 8 * c) = o; }
    __syncthreads();
}
__device__ __forceinline__ void sincos_d(float af, float& c, float& s) {
    const double a = (double)af; const double TWO_PI = 6.283185307179586476925287, INV_2PI = 0.15915494309189533576888;
    const double n = rint(a * INV_2PI); double r = a - n * TWO_PI;
    r *= 0.25; const double r2 = r * r;
    double sn = r * (1.0 + r2 * (-1.0 / 6 + r2 * (1.0 / 120 + r2 * (-1.0 / 5040 + r2 * (1.0 / 362880 + r2 * (-1.0 / 39916800 + r2 * (1.0 / 6227020800.0)))))));
    double cs = 1.0 + r2 * (-0.5 + r2 * (1.0 / 24 + r2 * (-1.0 / 720 + r2 * (1.0 / 40320 + r2 * (-1.0 / 3628800 + r2 * (1.0 / 479001600.0 + r2 * (-1.0 / 87178291200.0)))))));
#pragma unroll
    for (int i = 0; i < 2; ++i) { const double s2 = 2.0 * sn * cs, c2 = cs * cs - sn * sn; sn = s2; cs = c2; }
    c = (float)cs; s = (float)sn;
}

typedef __attribute__((address_space(1))) unsigned gu32;
#define XB_TMO      128
#define XB_XCNT(j)  (256  + 64 * (j))
#define XB_XSUB(j)  (1280 + 64 * (j))
#define XB_XGEN(j)  (2304 + 64 * (j))
#define XB_TOP      3328
#define XB_TOPGEN   3392
#define XCD_BAR_WORDS 3456
#define XB_SPIN_CAP (1u << 18)

__device__ __forceinline__ unsigned xb_ld(unsigned* p)              { return __hip_atomic_load(p, __ATOMIC_RELAXED, __HIP_MEMORY_SCOPE_AGENT); }
__device__ __forceinline__ unsigned xb_add(unsigned* p, unsigned v) { return __hip_atomic_fetch_add(p, v, __ATOMIC_RELAXED, __HIP_MEMORY_SCOPE_AGENT); }
__device__ __forceinline__ unsigned xb_xcc_id() { return (unsigned)__builtin_amdgcn_s_getreg((3 << 11) | 20) & 0xFu; }
#define XB_SPIN(cond, bar) do { unsigned _sp = 0; while (cond) { __builtin_amdgcn_s_sleep(1); \
    if ((++_sp & 255u) == 0u) { if (xb_ld(&(bar)[XB_TMO])) break; if (_sp > XB_SPIN_CAP) { atomicAdd(&(bar)[XB_TMO], 1u); break; } } } } while (0)

struct XcdBarrier {
    unsigned* bar; unsigned x;
    volatile LAS unsigned* st;
};

__device__ __forceinline__ XcdBarrier xcd_barrier_post(unsigned* bar, volatile LAS unsigned* st, bool leader) {
    XcdBarrier b; b.bar = bar; b.x = xb_xcc_id(); b.st = st;
    if (leader) (void)xb_add(&bar[XB_XCNT(b.x)], 1u);
    return b;
}
__device__ __forceinline__ void xcd_barrier_complete(unsigned* bar, unsigned x, unsigned& nloc, unsigned& nx) {
    const unsigned G = gridDim.x * gridDim.y * gridDim.z;
    unsigned sum, cnt, mine, sp = 0u;
    for (;;) {
        sum = 0u; cnt = 0u; mine = 0u;
#pragma unroll
        for (unsigned j = 0; j < 16; ++j) { const unsigned c = xb_ld(&bar[XB_XCNT(j)]); sum += c; cnt += (c > 0u) ? 1u : 0u; mine = (j == x) ? c : mine; }
        if (sum == G) break;
        __builtin_amdgcn_s_sleep(1);
        if ((++sp & 255u) == 0u) { if (xb_ld(&bar[XB_TMO])) break; if (sp > XB_SPIN_CAP) { atomicAdd(&bar[XB_TMO], 1u); break; } }
    }
    nloc = mine > 0u ? mine : 1u; nx = cnt > 0u ? cnt : 1u;
}

__device__ __forceinline__ void xcd_barrier(const XcdBarrier& b, bool leader) {
    asm volatile("s_waitcnt vmcnt(0)" ::: "memory");
    __syncthreads();
    if (leader) {
        unsigned* bar = b.bar;
        __builtin_amdgcn_s_waitcnt(0);
        unsigned nloc = b.st[0], nx = b.st[1];
        if (nloc == 0u) { xcd_barrier_complete(bar, b.x, nloc, nx); b.st[0] = nloc; b.st[1] = nx; }
        const unsigned old = xb_add(&bar[XB_XSUB(b.x)], 1u);
        const unsigned gen = old / nloc;
        if (old + 1u == (gen + 1u) * nloc) {
            __builtin_amdgcn_fence(__ATOMIC_RELEASE, "agent");
            asm volatile("s_waitcnt vmcnt(0)" ::: "memory");
            const unsigned og = xb_add(&bar[XB_TOP], 1u);
            const unsigned tg = og / nx;
            if (og + 1u == (tg + 1u) * nx) xb_add(&bar[XB_TOPGEN], 1u);
            else XB_SPIN(xb_ld(&bar[XB_TOPGEN]) == tg, bar);
            __builtin_amdgcn_fence(__ATOMIC_ACQUIRE, "agent");
            xb_add(&bar[XB_XGEN(b.x)], 1u);
            asm volatile("s_waitcnt vmcnt(0)" ::: "memory");
        } else {
            XB_SPIN(xb_ld(&bar[XB_XGEN(b.x)]) == gen, bar);
            __builtin_amdgcn_fence(__ATOMIC_ACQUIRE, "agent");
            asm volatile("s_waitcnt vmcnt(0)" ::: "memory");
        }
    }
    __syncthreads();
}


struct Args { const float* in[22]; float* out; unsigned char* ws; };

__global__ void __launch_bounds__(NWAVES * 64, 2) fwd_mega(Args a) {
    extern __shared__ __attribute__((aligned(16))) unsigned char lds_raw[];
    cg::grid_group grid = cg::this_grid();
    LAS unsigned char* lds = (LAS unsigned char*)lds_raw;
    const int wave = __builtin_amdgcn_readfirstlane((int)threadIdx.x >> 6);
#define FRESH_LANE() ({ unsigned m_ = ~0u; asm volatile("" : "+s"(m_)); int l_ = (int)__builtin_amdgcn_mbcnt_hi(m_, __builtin_amdgcn_mbcnt_lo(m_, 0u)); l_; })
    volatile LAS unsigned* MISC = (volatile LAS unsigned*)(lds + RING_BYTES + 15360);
    { const int ln0 = FRESH_LANE(); if (wave == 0 && ln0 < 2) MISC[ln0] = 0u;
      if (blockIdx.x == 0) { unsigned* bw = (unsigned*)a.ws; for (int i = wave * 64 + ln0; i < XCD_BAR_WORDS; i += NWAVES * 64) bw[i] = 0u; } }
    __syncthreads();
    const int G = gridDim.x, bx = blockIdx.x; const int vcu = (G % 8 == 0) ? (bx % 8) * (G / 8) + bx / 8 : bx;
#define LOCALS() \
    int z_ = 0; asm volatile("" : "+s"(z_)); const float* const* in = a.in + z_; \
    unsigned char* ws = a.ws + z_; float* out = a.out + z_; const float* x = in[0]; \
    float* cosd = (float*)(ws + WS_COSD); float* sind = (float*)(ws + WS_SIND); float* cosm = (float*)(ws + WS_COSM); float* sinm = (float*)(ws + WS_SINM); \
    float* part = (float*)(ws + WS_PART); float* partq = (float*)(ws + WS_PARTQ); float* partkv = (float*)(ws + WS_PARTKV); \
    bf16* XB = (bf16*)(ws + WS_XB); bf16* MG = (bf16*)(ws + WS_MG); bf16* QB = (bf16*)(ws + WS_QB); bf16* KV = (bf16*)(ws + WS_KV); bf16* HP = (bf16*)(ws + WS_HP); \
    (void)x; (void)out; (void)cosd; (void)sind; (void)cosm; (void)sinm; (void)part; (void)partq; (void)partkv; (void)XB; (void)MG; (void)QB; (void)KV; (void)HP
    const int gw = vcu * NWAVES + wave, NGW = G * NWAVES;

    {
        LOCALS();
        const int lane = FRESH_LANE(), tid = wave * 64 + lane;
        LAS float* scr = (LAS float*)(lds + wave * 16640);
        constexpr int I_GU = 16 * 88, I_D = 44 * 16, I_IN = 16 * 44, I_UQ = 4 * 8, I_UKV = 4 * 8, I_OUT = 16 * 16;
        constexpr int I_LAYER = 2 * I_GU + 2 * I_D + I_IN + I_UQ + I_UKV + I_OUT;
        constexpr int T_GU = 8 * 22, T_D = 22 * 4, T_IN = 8 * 11, T_UQ = 2 * 2, T_UKV = 2 * 2, T_OUT = 8 * 4, T_LAYER = 2 * T_GU + 2 * T_D + T_IN + T_UQ + T_UKV + T_OUT;
        LAS float* img = (LAS float*)lds;
        for (int tl = vcu; tl < DEPTH * T_LAYER; tl += G) {
            const int l = tl / T_LAYER; int r = tl % T_LAYER; bf16* wl = (bf16*)(ws + WS_W + l * WS_WL);
            if (r < T_GU) { wt_tile(in[2] + (size_t)l * D * DFF, in[3] + (size_t)l * D * DFF, in[1] + l * D, (bf16*)((char*)wl + W_GU1), D, D, DFF, 2 * DFF, 1, img, r, wave, lane); continue; } r -= T_GU;
            if (r < T_D) { wt_tile(in[4] + (size_t)l * DFF * D, nullptr, nullptr, (bf16*)((char*)wl + W_D1), DFF, DFF, D, D, 0, img, r, wave, lane); continue; } r -= T_D;
            if (r < T_IN) { wt_tile(in[6] + (size_t)l * D * IN_SRC, nullptr, in[5] + l * D, (bf16*)((char*)wl + W_IN), D, D, IN_SRC, NIN, 2, img, r, wave, lane); continue; } r -= T_IN;
            if (r < T_UQ) { wt_tile(in[13] + (size_t)l * 256 * 384, nullptr, in[12] + l * 256, (bf16*)((char*)wl + W_UQ), 256, 256, 384, 512, 3, img, r, wave, lane); continue; } r -= T_UQ;
            if (r < T_UKV) { wt_tile(in[15] + (size_t)l * 128 * 512, nullptr, in[14] + l * 128, (bf16*)((char*)wl + W_UKV), 128, 256, 512, 512, 0, img, r, wave, lane); continue; } r -= T_UKV;
            if (r < T_OUT) { wt_tile(in[16] + (size_t)l * D * D, nullptr, nullptr, (bf16*)((char*)wl + W_OUT), D, D, D, D, 0, img, r, wave, lane); continue; } r -= T_OUT;
            if (r < T_GU) { wt_tile(in[18] + (size_t)l * D * DFF, in[19] + (size_t)l * D * DFF, in[17] + l * D, (bf16*)((char*)wl + W_GU2), D, D, DFF, 2 * DFF, 1, img, r, wave, lane); continue; } r -= T_GU;
            wt_tile(in[20] + (size_t)l * DFF * D, nullptr, nullptr, (bf16*)((char*)wl + W_D2), DFF, DFF, D, D, 0, img, r, wave, lane);
        }
        for (int i = bx * 512 + tid; i < SEQ * 24; i += G * 512) {
            const int pos = i / 24, k = i % 24; float c, s;
            if (k < 8) { const float inv = (float)exp2(-(double)(2 * k) / 16.0 * 18.931568569324174  ); sincos_d((float)pos * inv, c, s); cosd[pos * 8 + k] = c; sind[pos * 8 + k] = s; }
            else { const int kk = k - 8; const float inv = (float)exp2(-(double)(2 * kk) / 32.0 * 18.931568569324174); sincos_d((float)pos * inv, c, s); cosm[pos * 16 + kk] = c; sinm[pos * 16 + kk] = s; }
        }
        for (int m0 = gw * 4; m0 < M; m0 += NGW * 4) {
            f32x4 v[4][4]; float s[4];
#pragma unroll
            for (int r = 0; r < 4; ++r) { const f32x4* xr = (const f32x4*)(x + (size_t)(m0 + r) * D) + lane;
#pragma unroll
                for (int j = 0; j < 4; ++j) v[r][j] = xr[64 * j]; }
#pragma unroll
            for (int r = 0; r < 4; ++r) { float t = 0.f;
#pragma unroll
                for (int j = 0; j < 4; ++j) t += (v[r][j].x * v[r][j].x + v[r][j].y * v[r][j].y) + (v[r][j].z * v[r][j].z + v[r][j].w * v[r][j].w);
                s[r] = wave_sum(t); }
#pragma unroll
            for (int r = 0; r < 4; ++r) { unsigned long long* o8 = (unsigned long long*)(XB + (size_t)(m0 + r) * D) + lane;
#pragma unroll
                for (int j = 0; j < 4; ++j) o8[64 * j] = (unsigned long long)pk2(v[r][j].x, v[r][j].y) | ((unsigned long long)pk2(v[r][j].z, v[r][j].w) << 32); }
            { const int r = lane >> 4, c = lane & 15; const float sv = r == 0 ? s[0] : r == 1 ? s[1] : r == 2 ? s[2] : s[3]; part[(size_t)(m0 + r) * 16 + c] = c == 0 ? sv : 0.f; }
        }
    }
    grid.sync();
    XcdBarrier bar = xcd_barrier_post((unsigned*)a.ws, MISC, wave == 0 && FRESH_LANE() == 0);

    const float QS64 = 0.125f * 1.4426950408889634f, QS96 = 0.10206207261596575f * 1.4426950408889634f;
    for (int st = 0; st < DEPTH * 8; ++st) {
        LOCALS();
        const int l = st >> 3, k = st & 7;
        const unsigned char* wl = ws + WS_W + (size_t)l * WS_WL;
        if (0) {}
#ifndef NO_UP
        else if (k == 0 || k == 6) {
            pg8::Gemm g{XB, (const bf16*)(wl + (k == 0 ? W_GU1 : W_GU2)), M, 2 * DFF, D, D, D}; pg8::StaticOrder S; S.init(M, 2 * DFF, G, bx);
            LAS float* rst = (LAS float*)(lds + RING_BYTES); pg8::fill_rowscale<16>(rst, S, part, 1.0f / 1024.0f, 1.0f, wave * 64 + FRESH_LANE());
            pg8::EpiUp E{HP, rst, DFF};
            pg8::gemm_phase<pg8::EpiUp, pg8::StaticOrder, true, true>(lds, g, S, E, wave);
        }
#endif
#ifndef NO_RES
        else if (k == 1 || k == 7 || k == 5) {
            const bool wo = (k == 5);
            pg8::Gemm g{wo ? MG : HP, (const bf16*)(wl + (k == 1 ? W_D1 : k == 7 ? W_D2 : W_OUT)), M, D, wo ? D : DFF, wo ? D : DFF, wo ? D : DFF}; pg8::StaticOrder S; S.init(M, D, G, bx);
            pg8::EpiRes E{XB, part, wo ? 1.0f : 0.5f};
            pg8::gemm_phase<pg8::EpiRes, pg8::StaticOrder, true, true>(lds, g, S, E, wave);
        }
#endif
#ifndef NO_IN
        else if (k == 2) {
            pg8::Gemm g{XB, (const bf16*)(wl + W_IN), M, NIN, D, D, D}; pg8::StaticOrder S; S.init(M, NIN, G, bx);
            LAS float* rst = (LAS float*)(lds + RING_BYTES); pg8::fill_rowscale<16>(rst, S, part, 1.0f / 1024.0f, 1.0f, wave * 64 + FRESH_LANE());
            pg8::EpiIn E{HP, rst, partq, partkv, cosd, sind, cosm, sinm, NIN, QS64};
            pg8::gemm_phase<pg8::EpiIn, pg8::StaticOrder, true, true>(lds, g, S, E, wave);
        }
#endif
#ifndef NO_MLA
        else if (k == 3) {
            { pg8::Gemm g{HP + 6 * 256, (const bf16*)(wl + W_UQ), M, 512, 256, NIN, 256}; pg8::StaticOrder S; S.init(M, 512, G, bx);
              LAS float* rst = (LAS float*)(lds + RING_BYTES); pg8::fill_rowscale<4>(rst, S, partq, 1.0f / 256.0f, QS96, wave * 64 + FRESH_LANE());
              pg8::EpiMla<true> E{QB, rst, cosm, sinm, 512};
              pg8::gemm_phase<pg8::EpiMla<true>, pg8::StaticOrder, true, true>(lds, g, S, E, wave); }
            { pg8::Gemm g{HP + 7 * 256, (const bf16*)(wl + W_UKV), M, 512, 256, NIN, 256}; pg8::StaticOrder S; S.init(M, 512, G, bx);
              LAS float* rst = (LAS float*)(lds + RING_BYTES) + 1024; pg8::fill_rowscale<4>(rst, S, partkv, 1.0f / 128.0f, 1.0f, wave * 64 + FRESH_LANE());
              pg8::EpiMla<false> E{KV, rst, cosm, sinm, 512};
              pg8::gemm_phase<pg8::EpiMla<false>, pg8::StaticOrder, true, true>(lds, g, S, E, wave); }
        }
#endif
#ifndef NO_ATT
        else {
            const float li = 0.8f - 0.6f * expf(-0.3f * (float)l);
            const int lane = FRESH_LANE();
            float v1 = in[7][l * 64 + lane] * in[8][l * 64 + lane], v2 = in[9][l * 64 + lane] * in[10][l * 64 + lane];
            v1 = wave_sum(v1); v2 = wave_sum(v2);
            const float lam = expf(v1) - expf(v2) + li;
            const float* subln = in[11] + l * 128;
            for (int pr = vcu; pr < 256; pr += G) { const int bh = pr >> 3, s = pr & 7, b = bh >> 2, h = bh & 3;
#ifndef NO_DIFF
#pragma clang loop unroll(disable)
                for (int rep = 0; rep < 2; ++rep) { const int ln = FRESH_LANE();
                    f32x4* stash = (f32x4*)(ws + WS_STASH) + ((size_t)(bx * NWAVES + wave) * 16) * 64 + ln;
                    att::diff_unit(b, h, rep ? 15 - s : s, HP, NIN, MG, subln, lam, 1.0f - li, stash, (LAS char*)lds, wave * 64 + ln, ln, wave); }
#endif
#ifndef NO_MLAU
#pragma clang loop unroll(disable)
                for (int rep = 0; rep < 2; ++rep) { const int ln = FRESH_LANE();
                    att::mla_unit(b, h, rep ? 15 - s : s, HP, NIN, QB, KV, MG, (LAS char*)lds, wave * 64 + ln, ln, wave); }
#endif
            }
            __syncthreads();
#ifndef NO_SB
#pragma clang loop unroll(disable)
            for (int u = bx * NWAVES + wave; u < BATCH * 4 * 128; u += NGW) { const int b = u >> 9, h = (u >> 7) & 3, qb32 = u & 127; const int ln = FRESH_LANE();
                att::sb_unit(b, h, qb32, HP, NIN, MG, (LAS char*)lds + att::LDS_SBV + wave * 8192, ln); }
#endif
            __syncthreads();
        }
#endif
        xcd_barrier(bar, wave == 0 && FRESH_LANE() == 0);
    }
    {
        LOCALS();
        const int lane = FRESH_LANE();
        const float* gn = in[21];
        f32x4 g4[2][2];
#pragma unroll
        for (int j = 0; j < 2; ++j) { g4[j][0] = *(const f32x4*)(gn + 8 * lane + 512 * j); g4[j][1] = *(const f32x4*)(gn + 8 * lane + 512 * j + 4); }
        for (int m0 = gw * 4; m0 < M; m0 += NGW * 4) {
            v4u raw[4][2];
#pragma unroll
            for (int r = 0; r < 4; ++r)
#pragma unroll
                for (int j = 0; j < 2; ++j) raw[r][j] = *(const v4u*)(XB + (size_t)(m0 + r) * D + 8 * lane + 512 * j);
#pragma unroll
            for (int r = 0; r < 4; ++r) { f32x4 v[2][2]; float t = 0.f;
#pragma unroll
                for (int j = 0; j < 2; ++j) { const v4u w = raw[r][j];
                    v[j][0] = (f32x4){__builtin_bit_cast(float, w.x << 16), __builtin_bit_cast(float, w.x & 0xffff0000u), __builtin_bit_cast(float, w.y << 16), __builtin_bit_cast(float, w.y & 0xffff0000u)};
                    v[j][1] = (f32x4){__builtin_bit_cast(float, w.z << 16), __builtin_bit_cast(float, w.z & 0xffff0000u), __builtin_bit_cast(float, w.w << 16), __builtin_bit_cast(float, w.w & 0xffff0000u)};
                    t += (v[j][0].x * v[j][0].x + v[j][0].y * v[j][0].y) + (v[j][0].z * v[j][0].z + v[j][0].w * v[j][0].w) + (v[j][1].x * v[j][1].x + v[j][1].y * v[j][1].y) + (v[j][1].z * v[j][1].z + v[j][1].w * v[j][1].w); }
                const float rs = 1.0f / sqrtf(wave_sum(t) * (1.0f / D) + 1e-6f);
                float* xo = out + (size_t)(m0 + r) * D + 8 * lane;
#pragma unroll
                for (int j = 0; j < 2; ++j) { *(f32x4*)(xo + 512 * j) = v[j][0] * rs * g4[j][0]; *(f32x4*)(xo + 512 * j + 4) = v[j][1] * rs * g4[j][1]; } }
        }
    }
}

extern "C" void kernel_launch(void* const* d_in, const int* in_sizes, int n_in, void* d_out, int out_size, void* d_ws, size_t ws_size, hipStream_t stream) {
    static int grid = 0;
    if (grid == 0) {
        if (n_in != 22 || ws_size < WS_END) { fprintf(stderr, "kernel_launch: unexpected n_in %d / ws %zu\n", n_in, ws_size); grid = -1; return; }
        int dev = 0, cus = 0, per_cu = 0;
        (void)hipGetDevice(&dev); (void)hipDeviceGetAttribute(&cus, hipDeviceAttributeMultiprocessorCount, dev);
        (void)hipFuncSetAttribute((const void*)fwd_mega, hipFuncAttributeMaxDynamicSharedMemorySize, LDS_BYTES);
        (void)hipOccupancyMaxActiveBlocksPerMultiprocessor(&per_cu, (const void*)fwd_mega, NWAVES * 64, LDS_BYTES);
        if (per_cu < 1) { fprintf(stderr, "kernel_launch: occupancy query says %d blocks per CU\n", per_cu); per_cu = 1; }
        (void)hipGetLastError();
        grid = cus * per_cu;
    }
    if (grid < 0) return;
    Args a{};
    for (int i = 0; i < 22; ++i) a.in[i] = (const float*)d_in[i];
    a.out = (float*)d_out; a.ws = (unsigned char*)d_ws;
    void* args[] = {&a};
    hipError_t e = hipLaunchCooperativeKernel((const void*)fwd_mega, dim3(grid), dim3(NWAVES * 64), args, LDS_BYTES, stream);
    if (e != hipSuccess) fprintf(stderr, "cooperative launch failed: %s (grid %d)\n", hipGetErrorString(e), grid);
}
```

```cpp
#include <hip/hip_runtime.h>
#include <hip/hip_cooperative_groups.h>
#include <hip/hip_bf16.h>
#include <cstdio>
#include <cstdint>
namespace cg = cooperative_groups;
#define SWZ_XOR(v, o) __builtin_bit_cast(float, __builtin_amdgcn_ds_swizzle(__builtin_bit_cast(int, (float)(v)), (((o) << 10) | 0x1F)))
__device__ __forceinline__ float x32_sum(float v) { auto rr = __builtin_amdgcn_permlane32_swap(__builtin_bit_cast(unsigned, v), __builtin_bit_cast(unsigned, v), false, false); return __builtin_bit_cast(float, (unsigned)rr[0]) + __builtin_bit_cast(float, (unsigned)rr[1]); }
__device__ __forceinline__ float x32_max(float v) { auto rr = __builtin_amdgcn_permlane32_swap(__builtin_bit_cast(unsigned, v), __builtin_bit_cast(unsigned, v), false, false); return fmaxf(__builtin_bit_cast(float, (unsigned)rr[0]), __builtin_bit_cast(float, (unsigned)rr[1])); }
__device__ __forceinline__ float x32_other(float v, int hi) { auto rr = __builtin_amdgcn_permlane32_swap(__builtin_bit_cast(unsigned, v), __builtin_bit_cast(unsigned, v), false, false); return hi ? __builtin_bit_cast(float, (unsigned)rr[0]) : __builtin_bit_cast(float, (unsigned)rr[1]); }
__device__ __forceinline__ float wave_sum(float v) { v += SWZ_XOR(v, 1); v += SWZ_XOR(v, 2); v += SWZ_XOR(v, 4); v += SWZ_XOR(v, 8); v += SWZ_XOR(v, 16); return x32_sum(v); }
namespace pg8 {
#define PG8_LAS __attribute__((address_space(3)))
typedef unsigned short bf16_t;
typedef short bf16x8 __attribute__((ext_vector_type(8)));
typedef float f32x4 __attribute__((ext_vector_type(4)));
typedef unsigned u32x4 __attribute__((ext_vector_type(4)));
constexpr int BM = 256, BK = 64, HALF = 128, HTB = HALF * BK * 2  , STAGE_BYTES = 8 * HTB, NXCD = 8, WGM = 8;

__host__ __device__ __forceinline__ int lds_byte(int r, int c) { const int st = (r >> 4) * 2 + (c >> 5), rr = r & 15, cc = c & 31, ob = rr * 64 + cc * 2; return st * 1024 + (ob ^ (((ob >> 9) & 1) << 5)); }
__host__ __device__ __forceinline__ void stage_rc(int b, int& R, int& C) { const int st = b / 1024, sb = b % 1024, swz = sb ^ (((sb >> 9) & 1) << 5); R = (st >> 1) * 16 + swz / 64; C = (st & 1) * 32 + (swz % 64) / 2; }
__host__ __device__ __forceinline__ int perm32(int rho) { const int n = rho >> 4, i = rho & 15; return 8 * (i >> 2) + 4 * n + (i & 3); }

struct Unit { int pm, pn, ord; };
struct Gemm { const bf16_t* A; const bf16_t* Bt; int M, N, K, lda, ldb; };

struct StaticOrder {
    int nM, nN, nwg, G, c;
    __host__ __device__ void init(int M, int N, int G_, int c_) { nM = M / BM; nN = N / BM; nwg = nM * nN; G = G_; c = c_; }
    __host__ __device__ bool next(int i, Unit& u) const {
        const long L = (long)i * G + c; if (L >= nwg) return false;
        int wgid = (int)L; { const int q = nwg / NXCD, r = nwg % NXCD, xcd = wgid % NXCD, off = wgid / NXCD; wgid = (xcd < r ? xcd * (q + 1) : r * (q + 1) + (xcd - r) * q) + off; }
        const int nig = WGM * nN, gid = wgid / nig, fm = gid * WGM, gsz = (nM - fm) < WGM ? (nM - fm) : WGM;
        u.pm = fm + ((wgid % nig) % gsz); u.pn = (wgid % nig) / gsz; u.ord = i; return true;
    }
    __device__ __forceinline__ void a_ready(const Unit&) const {}
    __device__ __forceinline__ void done(const Unit&) const {}
};

typedef float f32x2 __attribute__((ext_vector_type(2)));
typedef __bf16 bf16x2_t __attribute__((ext_vector_type(2)));
typedef unsigned u32x2 __attribute__((ext_vector_type(2)));
__device__ __forceinline__ unsigned cvt_pk_bf16(float lo, float hi) { f32x2 v = {lo, hi}; bf16x2_t b = __builtin_convertvector(v, bf16x2_t); return __builtin_bit_cast(unsigned, b); }
constexpr float RMS_EPS = 1e-6f;
constexpr float LOG2E = 1.4426950408889634f;
__device__ __forceinline__ float sum16(const float* p) { const f32x4 a = *(const f32x4*)p, b = *(const f32x4*)(p + 4), c = *(const f32x4*)(p + 8), d = *(const f32x4*)(p + 12);
    return ((a[0] + a[1]) + (a[2] + a[3])) + ((b[0] + b[1]) + (b[2] + b[3])) + ((c[0] + c[1]) + (c[2] + c[3])) + ((d[0] + d[1]) + (d[2] + d[3])); }
__device__ __forceinline__ float sum4(const float* p) { const f32x4 a = *(const f32x4*)p; return (a[0] + a[1]) + (a[2] + a[3]); }
__device__ __forceinline__ float dot4(const f32x4 a) { return (a[0] * a[0] + a[1] * a[1]) + (a[2] * a[2] + a[3] * a[3]); }
__device__ __forceinline__ void rope4(f32x4& x1, f32x4& x2, const f32x4 c, const f32x4 s) { const f32x4 a = x1 * c - x2 * s, b = x2 * c + x1 * s; x1 = a; x2 = b; }

struct EpiUp {
    static constexpr bool PERM = true, AFTER_DRAIN = false;
    bf16_t* H; const PG8_LAS float* rst; int ldh;
    __device__ __forceinline__ void operator()(const f32x4 (&acc)[2][2][4][2], const Unit& u, int wr, int wc, int fr, int fq) const {
        const int rl0 = wr * 64 + fr, row0 = u.pm * BM + rl0, col0 = u.pn * HALF + wc * 32 + 8 * fq;
        const PG8_LAS float* rt = rst + u.ord * BM + rl0;
#pragma unroll
        for (int ai = 0; ai < 2; ++ai)
#pragma unroll
            for (int m = 0; m < 4; ++m) { const int row = row0 + ai * HALF + m * 16;
                const float rs = rt[ai * HALF + m * 16], rs2 = rs * rs, c1 = -rs * LOG2E;
                float hv[8];
#pragma unroll
                for (int n = 0; n < 2; ++n)
#pragma unroll
                    for (int e = 0; e < 4; ++e) { const float ag = acc[ai][0][m][n][e], au = acc[ai][1][m][n][e];
                        hv[n * 4 + e] = (ag * au) * (rs2 * __builtin_amdgcn_rcpf(1.0f + __builtin_amdgcn_exp2f(ag * c1))); }
                u32x4 w; w.x = cvt_pk_bf16(hv[0], hv[1]); w.y = cvt_pk_bf16(hv[2], hv[3]); w.z = cvt_pk_bf16(hv[4], hv[5]); w.w = cvt_pk_bf16(hv[6], hv[7]);
                *(u32x4*)(H + (size_t)row * ldh + col0) = w; }
    }
};
__device__ __forceinline__ float bf_lo(unsigned w) { return __builtin_bit_cast(float, w << 16); }
__device__ __forceinline__ float bf_hi(unsigned w) { return __builtin_bit_cast(float, w & 0xffff0000u); }
struct EpiRes {
    static constexpr bool PERM = true, AFTER_DRAIN = false;
    bf16_t* xb; float* part; float s;
    __device__ __forceinline__ void operator()(const f32x4 (&acc)[2][2][4][2], const Unit& u, int wr, int wc, int fr, int fq) const {
        const int row0 = u.pm * BM + wr * 64 + fr, col0 = u.pn * BM + wc * 32 + 8 * fq;
#pragma unroll
        for (int ai = 0; ai < 2; ++ai) {
            u32x4 pre[4][2];
#pragma unroll
            for (int m = 0; m < 4; ++m) { const size_t off = (size_t)(row0 + ai * HALF + m * 16) * 1024 + col0;
#pragma unroll
                for (int bj = 0; bj < 2; ++bj) pre[m][bj] = *(const u32x4*)(xb + off + bj * HALF); }
#pragma unroll
            for (int m = 0; m < 4; ++m) { const int row = row0 + ai * HALF + m * 16; const size_t off = (size_t)row * 1024 + col0; float ss = 0.f;
#pragma unroll
                for (int bj = 0; bj < 2; ++bj) { const u32x4 b = pre[m][bj];
                    const f32x4 v0 = (f32x4){bf_lo(b.x), bf_hi(b.x), bf_lo(b.y), bf_hi(b.y)} + acc[ai][bj][m][0] * s;
                    const f32x4 v1 = (f32x4){bf_lo(b.z), bf_hi(b.z), bf_lo(b.w), bf_hi(b.w)} + acc[ai][bj][m][1] * s;
                    u32x4 w; w.x = cvt_pk_bf16(v0[0], v0[1]); w.y = cvt_pk_bf16(v0[2], v0[3]); w.z = cvt_pk_bf16(v1[0], v1[1]); w.w = cvt_pk_bf16(v1[2], v1[3]);
                    *(u32x4*)(xb + off + bj * HALF) = w; ss += dot4(v0) + dot4(v1); }
                ss += SWZ_XOR(ss, 16); ss = x32_sum(ss);
                if (fq == 0) part[(size_t)row * 16 + u.pn * 4 + wc] = ss; }
            asm volatile("" ::: "memory"); }
    }
};
struct EpiIn {
    static constexpr bool PERM = true, AFTER_DRAIN = false;
    bf16_t* P; const PG8_LAS float* rst; float* partq; float* partkv; const float* cosd; const float* sind; const float* cosm; const float* sinm; int ldp; float qscale;
    __device__ __forceinline__ void operator()(const f32x4 (&acc)[2][2][4][2], const Unit& u, int wr, int wc, int fr, int fq) const {
        const int tile = u.pn; const int rl0 = wr * 64 + fr, row0 = u.pm * BM + rl0, col0 = tile * BM + wc * 32 + 8 * fq;
        const PG8_LAS float* rt = rst + u.ord * BM + rl0;
        const float cs = (tile < 2 || tile == 8) ? qscale : 1.0f;
        const bool ropeD = (tile < 4) && ((wc & 1) == 0) && (fq < 2);
        const bool ropeM = (tile == 7) && (wc == 0);
        const float* ct = ropeD ? cosd : cosm; const float* sn = ropeD ? sind : sinm; const int sh = ropeD ? 3 : 4;
#pragma unroll
        for (int ai = 0; ai < 2; ++ai) {
            f32x4 rc[4], rsn[4];
            if (ropeD || ropeM) {
#pragma unroll
                for (int m = 0; m < 4; ++m) { const int pos = (row0 + ai * HALF + m * 16) & 4095; rc[m] = *(const f32x4*)(ct + (pos << sh) + 4 * fq); rsn[m] = *(const f32x4*)(sn + (pos << sh) + 4 * fq); } }
#pragma unroll
            for (int m = 0; m < 4; ++m) { const int row = row0 + ai * HALF + m * 16;
                const float rs = cs * rt[ai * HALF + m * 16];
                f32x4 v[2][2];
#pragma unroll
                for (int bj = 0; bj < 2; ++bj)
#pragma unroll
                    for (int n = 0; n < 2; ++n) v[bj][n] = acc[ai][bj][m][n] * rs;
                if (ropeD) { rope4(v[0][0], v[0][1], rc[m], rsn[m]); rope4(v[1][0], v[1][1], rc[m], rsn[m]); }
                if (ropeM) { rope4(v[1][0], v[1][1], rc[m], rsn[m]); }
                if (tile == 6) { float ss = (dot4(v[0][0]) + dot4(v[0][1])) + (dot4(v[1][0]) + dot4(v[1][1])); ss += SWZ_XOR(ss, 16); ss = x32_sum(ss); if (fq == 0) partq[(size_t)row * 4 + wc] = ss; }
                if (tile == 7) { float ss = dot4(v[0][0]) + dot4(v[0][1]); ss += SWZ_XOR(ss, 16); ss = x32_sum(ss); if (fq == 0) partkv[(size_t)row * 4 + wc] = ss; }
#pragma unroll
                for (int bj = 0; bj < 2; ++bj) { u32x4 w; w.x = cvt_pk_bf16(v[bj][0][0], v[bj][0][1]); w.y = cvt_pk_bf16(v[bj][0][2], v[bj][0][3]); w.z = cvt_pk_bf16(v[bj][1][0], v[bj][1][1]); w.w = cvt_pk_bf16(v[bj][1][2], v[bj][1][3]);
                    *(u32x4*)(P + (size_t)row * ldp + col0 + bj * HALF) = w; }
                asm volatile("" ::: "memory"); } }
    }
};
template <bool ROPE> struct EpiMla {
    static constexpr bool PERM = true, AFTER_DRAIN = false;
    bf16_t* O; const PG8_LAS float* rst; const float* cosm; const float* sinm; int ldo;
    __device__ __forceinline__ void operator()(const f32x4 (&acc)[2][2][4][2], const Unit& u, int wr, int wc, int fr, int fq) const {
        const int rl0 = wr * 64 + fr, row0 = u.pm * BM + rl0, col0 = u.pn * BM + wc * 32 + 8 * fq;
        const PG8_LAS float* rt = rst + u.ord * BM + rl0;
#pragma unroll
        for (int ai = 0; ai < 2; ++ai)
#pragma unroll
            for (int m = 0; m < 4; ++m) { const int row = row0 + ai * HALF + m * 16; const int pos = row & 4095;
                const float rs = rt[ai * HALF + m * 16];
                f32x4 v[2][2];
#pragma unroll
                for (int bj = 0; bj < 2; ++bj)
#pragma unroll
                    for (int n = 0; n < 2; ++n) v[bj][n] = acc[ai][bj][m][n] * rs;
                if (ROPE && wc == 2) { const f32x4 c = *(const f32x4*)(cosm + pos * 16 + 4 * fq), s = *(const f32x4*)(sinm + pos * 16 + 4 * fq); rope4(v[0][0], v[0][1], c, s); rope4(v[1][0], v[1][1], c, s); }
#pragma unroll
                for (int bj = 0; bj < 2; ++bj) { u32x4 w; w.x = cvt_pk_bf16(v[bj][0][0], v[bj][0][1]); w.y = cvt_pk_bf16(v[bj][0][2], v[bj][0][3]); w.z = cvt_pk_bf16(v[bj][1][0], v[bj][1][1]); w.w = cvt_pk_bf16(v[bj][1][2], v[bj][1][3]);
                    *(u32x4*)(O + (size_t)row * ldo + col0 + bj * HALF) = w; }
                asm volatile("" ::: "memory"); }
    }
};

template <int NP, class Sched>
__device__ __forceinline__ void fill_rowscale(PG8_LAS float* tab, const Sched& S, const float* parts, float inv_n, float scale, int tid) {
    Unit u; int nu = 0; while (S.next(nu, u)) ++nu;
    constexpr bool WIDE = (NP == 16);
    const int r0 = WIDE ? (tid >> 2) : (tid & 255), q = WIDE ? (tid & 3) : 0;
    const bool on = WIDE || tid < 256;
    f32x4 c0 = {0.f, 0.f, 0.f, 0.f}, c1 = c0, n0 = c0, n1 = c0;
    if (nu > 0 && on) { S.next(0, u); const float* p = parts + ((size_t)u.pm * BM + r0) * NP + q * 4; c0 = *(const f32x4*)p; if (WIDE) c1 = *(const f32x4*)(p + 128 * NP); }
    for (int i = 0; i < nu; ++i) {
        if (i + 1 < nu && on) { S.next(i + 1, u); const float* p = parts + ((size_t)u.pm * BM + r0) * NP + q * 4; n0 = *(const f32x4*)p; if (WIDE) n1 = *(const f32x4*)(p + 128 * NP); }
        float s0 = (c0[0] + c0[1]) + (c0[2] + c0[3]), s1 = (c1[0] + c1[1]) + (c1[2] + c1[3]);
        if (WIDE) { s0 += SWZ_XOR(s0, 1); s0 += SWZ_XOR(s0, 2); s1 += SWZ_XOR(s1, 1); s1 += SWZ_XOR(s1, 2); }
        if (on && q == 0) { tab[i * BM + r0] = scale / sqrtf(s0 * inv_n + RMS_EPS); if (WIDE) tab[i * BM + 128 + r0] = scale / sqrtf(s1 * inv_n + RMS_EPS); }
        c0 = n0; c1 = n1;
    }
    asm volatile("s_waitcnt lgkmcnt(0)" ::: "memory"); __builtin_amdgcn_s_barrier(); asm volatile("" ::: "memory");
}
template <class Epi, class Sched, bool ALIGN_EPI = false, bool SP2 = false>
__device__ __forceinline__ void gemm_phase(PG8_LAS unsigned char* lds, const Gemm g, const Sched& S, const Epi& E, int wave_in  ) {
    unsigned m_ = ~0u; asm volatile("" : "+s"(m_), "+s"(wave_in)); const int tid_ = wave_in * 64 + (int)__builtin_amdgcn_mbcnt_hi(m_, __builtin_amdgcn_mbcnt_lo(m_, 0u));
    const int tid = tid_, wid = __builtin_amdgcn_readfirstlane(tid >> 6), lane = tid & 63, wr = wid >> 2, wc = wid & 3, fr = lane & 15, fq = lane >> 4;
    const int K = g.K, nt = K / BK;
    unsigned voffA[2], voffB[2];
#pragma unroll
    for (int i = 0; i < 2; ++i) { int R, C; stage_rc(tid * 16 + i * 8192, R, C); const int Rb = Epi::PERM ? ((R & ~31) + perm32(R & 31)) : R;
        voffA[i] = (unsigned)(R * g.lda + C) * 2u; voffB[i] = (unsigned)(Rb * g.ldb + C) * 2u; }
    const size_t kstep = (size_t)(BK * 2);
    const size_t hstepA = (size_t)HALF * g.lda * 2, hstepB = (size_t)HALF * g.ldb * 2;
    const size_t tstepA = 2 * hstepA, tstepB = 2 * hstepB;
    const unsigned ldsw = (unsigned)wid * 1024u;
    const int aoff = lds_byte(wr * 64 + fr, fq * 8), boff = lds_byte(wc * 32 + fr, fq * 8);
#define PG8_SA(b, h) (((b) * 2 + (h)) * HTB)
#define PG8_SB(b, h) ((4 + (b) * 2 + (h)) * HTB)
#define PG8_STAGE(bufoff, gbase, voff) do { _Pragma("unroll") for (int _i = 0; _i < 2; ++_i) \
        __builtin_amdgcn_global_load_lds((const unsigned*)((const char*)(gbase) + (voff)[_i]), (PG8_LAS unsigned*)(lds + (bufoff) + ldsw + _i * 8192), 16, 0, 0); } while (0)
#define PG8_LDA(dst, b, h) do { _Pragma("unroll") for (int m = 0; m < 4; ++m) _Pragma("unroll") for (int k = 0; k < 2; ++k) dst[m][k] = *(const PG8_LAS bf16x8*)(lds + PG8_SA(b, h) + aoff + m * 2048 + k * 1024); } while (0)
#define PG8_LDB(dst, b, h) do { _Pragma("unroll") for (int n = 0; n < 2; ++n) _Pragma("unroll") for (int k = 0; k < 2; ++k) dst[n][k] = *(const PG8_LAS bf16x8*)(lds + PG8_SB(b, h) + boff + n * 2048 + k * 1024); } while (0)
#define PG8_MMA(ai, bj, At, Bt) do { __builtin_amdgcn_s_setprio(1); _Pragma("unroll") for (int m = 0; m < 4; ++m) _Pragma("unroll") for (int n = 0; n < 2; ++n) _Pragma("unroll") for (int k = 0; k < 2; ++k) \
        acc[ai][bj][m][n] = __builtin_amdgcn_mfma_f32_16x16x32_bf16(Bt[n][k], At[m][k], acc[ai][bj][m][n], 0, 0, 0); __builtin_amdgcn_s_setprio(0); } while (0)
#define PG8_WAIT_V(n) asm volatile("s_waitcnt vmcnt(" #n ")" ::: "memory")
#define PG8_WAIT_L(n) asm volatile("s_waitcnt lgkmcnt(" #n ")" ::: "memory")
#define PG8_BAR __builtin_amdgcn_s_barrier()
#define PG8_SCHED __builtin_amdgcn_sched_barrier(0)
    Unit cur, nxt; int ui = 0;
    if (!S.next(0, cur)) return;
    f32x4 acc[2][2][4][2];
#pragma unroll
    for (int a = 0; a < 2; ++a)
#pragma unroll
        for (int b = 0; b < 2; ++b)
#pragma unroll
            for (int m = 0; m < 4; ++m)
#pragma unroll
                for (int n = 0; n < 2; ++n) acc[a][b][m][n] = (f32x4){0.f, 0.f, 0.f, 0.f};
    bf16x8 At[4][2], B0[2][2], B1[2][2];
    const char* cA = (const char*)g.A + (size_t)cur.pm * tstepA; const char* cB = (const char*)g.Bt + (size_t)cur.pn * tstepB;
    S.a_ready(cur);
    if constexpr (SP2) {
        PG8_STAGE(PG8_SB(0, 0), cB, voffB); PG8_STAGE(PG8_SB(0, 1), cB + hstepB, voffB); PG8_STAGE(PG8_SA(0, 0), cA, voffA); PG8_STAGE(PG8_SA(0, 1), cA + hstepA, voffA);
        if (wr == 1) PG8_BAR;
        PG8_WAIT_V(2); PG8_BAR;
        PG8_STAGE(PG8_SB(1, 0), cB + kstep, voffB); PG8_STAGE(PG8_SA(1, 0), cA + kstep, voffA); PG8_STAGE(PG8_SB(1, 1), cB + hstepB + kstep, voffB);
        PG8_WAIT_V(6); PG8_BAR;
    } else {
        PG8_STAGE(PG8_SB(0, 0), cB, voffB); PG8_STAGE(PG8_SA(0, 0), cA, voffA); PG8_STAGE(PG8_SB(0, 1), cB + hstepB, voffB); PG8_STAGE(PG8_SA(0, 1), cA + hstepA, voffA);
        if (wr == 1) PG8_BAR;
        PG8_WAIT_V(4); PG8_BAR;
        PG8_STAGE(PG8_SB(1, 0), cB + kstep, voffB); PG8_STAGE(PG8_SA(1, 0), cA + kstep, voffA); PG8_STAGE(PG8_SB(1, 1), cB + hstepB + kstep, voffB);
        PG8_WAIT_V(6); PG8_BAR;
    }
    for (;;) {
        const bool has_next = S.next(ui + 1, nxt);
        const char* nA = has_next ? (const char*)g.A + (size_t)nxt.pm * tstepA : cA; const char* nB = has_next ? (const char*)g.Bt + (size_t)nxt.pn * tstepB : cB;
        for (int t = 0; t < nt; t += 2) {
            const bool last = (t == nt - 2);
            const char* a1 = cA + (size_t)(t + 1) * kstep;
            const char* a2 = last ? nA : cA + (size_t)(t + 2) * kstep; const char* b2 = last ? nB : cB + (size_t)(t + 2) * kstep;
            const char* a3 = a2 + kstep; const char* b3 = b2 + kstep;
            if (last && has_next) S.a_ready(nxt);
            if constexpr (SP2) {
            PG8_LDB(B0, 0, 0); PG8_LDB(B1, 0, 1); PG8_SCHED; PG8_LDA(At, 0, 0); PG8_STAGE(PG8_SA(1, 1), a1 + hstepA, voffA);
            PG8_WAIT_V(8); PG8_WAIT_L(0); PG8_BAR; PG8_MMA(0, 0, At, B0); PG8_MMA(0, 1, At, B1); PG8_BAR; PG8_SCHED;
            PG8_LDA(At, 0, 1); PG8_STAGE(PG8_SB(0, 0), b2, voffB); PG8_STAGE(PG8_SB(0, 1), b2 + hstepB, voffB); PG8_STAGE(PG8_SA(0, 0), a2, voffA);
            PG8_WAIT_V(8); PG8_WAIT_L(0); PG8_BAR; PG8_MMA(1, 0, At, B0); PG8_MMA(1, 1, At, B1); PG8_BAR; PG8_SCHED;
            PG8_LDB(B0, 1, 0); PG8_LDB(B1, 1, 1); PG8_SCHED; PG8_LDA(At, 1, 0); PG8_STAGE(PG8_SA(0, 1), a2 + hstepA, voffA);
            PG8_WAIT_V(8); PG8_WAIT_L(0); PG8_BAR; PG8_MMA(0, 0, At, B0); PG8_MMA(0, 1, At, B1); PG8_BAR; PG8_SCHED;
            PG8_LDA(At, 1, 1); PG8_STAGE(PG8_SB(1, 0), b3, voffB); PG8_STAGE(PG8_SB(1, 1), b3 + hstepB, voffB); PG8_STAGE(PG8_SA(1, 0), a3, voffA);
            PG8_WAIT_V(8); PG8_WAIT_L(0); PG8_BAR; PG8_MMA(1, 0, At, B0); PG8_MMA(1, 1, At, B1); PG8_BAR; PG8_SCHED;
            } else {
            PG8_LDB(B0, 0, 0); PG8_SCHED; PG8_LDA(At, 0, 0); PG8_STAGE(PG8_SA(1, 1), a1 + hstepA, voffA);
            PG8_WAIT_L(8); PG8_BAR; PG8_WAIT_L(0); PG8_MMA(0, 0, At, B0); PG8_BAR; PG8_SCHED;
            PG8_LDB(B1, 0, 1); PG8_STAGE(PG8_SB(0, 0), b2, voffB);
            PG8_BAR; PG8_WAIT_L(0); PG8_MMA(0, 1, At, B1); PG8_BAR;
            PG8_LDA(At, 0, 1); PG8_STAGE(PG8_SA(0, 0), a2, voffA);
            PG8_BAR; PG8_WAIT_L(0); PG8_MMA(1, 0, At, B0); PG8_BAR; PG8_SCHED;
            PG8_STAGE(PG8_SB(0, 1), b2 + hstepB, voffB);
            PG8_WAIT_V(6); PG8_BAR; PG8_MMA(1, 1, At, B1); PG8_BAR;
            PG8_LDB(B0, 1, 0); PG8_SCHED; PG8_LDA(At, 1, 0); PG8_STAGE(PG8_SA(0, 1), a2 + hstepA, voffA);
            PG8_WAIT_L(8); PG8_BAR; PG8_WAIT_L(0); PG8_MMA(0, 0, At, B0); PG8_BAR; PG8_SCHED;
            PG8_LDB(B1, 1, 1); PG8_STAGE(PG8_SB(1, 0), b3, voffB);
            PG8_BAR; PG8_WAIT_L(0); PG8_MMA(0, 1, At, B1); PG8_BAR;
            PG8_LDA(At, 1, 1); PG8_STAGE(PG8_SA(1, 0), a3, voffA);
            PG8_BAR; PG8_WAIT_L(0); PG8_MMA(1, 0, At, B0); PG8_BAR; PG8_SCHED;
            PG8_STAGE(PG8_SB(1, 1), b3 + hstepB, voffB);
            PG8_WAIT_V(6); PG8_BAR; PG8_MMA(1, 1, At, B1); PG8_BAR;
            }
        }
        if constexpr (ALIGN_EPI) { if (wr == 0) PG8_BAR; }
        if constexpr (!Epi::AFTER_DRAIN) { unsigned m2_ = ~0u; asm volatile("" : "+s"(m2_)); const int ln_ = (int)__builtin_amdgcn_mbcnt_hi(m2_, __builtin_amdgcn_mbcnt_lo(m2_, 0u)); E(acc, cur, wr, wc, ln_ & 15, ln_ >> 4); S.done(cur); }
        if (!has_next) break;
#pragma unroll
        for (int a = 0; a < 2; ++a)
#pragma unroll
            for (int b = 0; b < 2; ++b)
#pragma unroll
                for (int m = 0; m < 4; ++m)
#pragma unroll
                    for (int n = 0; n < 2; ++n) acc[a][b][m][n] = (f32x4){0.f, 0.f, 0.f, 0.f};
        cur = nxt; cA = nA; cB = nB; ++ui;
        if constexpr (ALIGN_EPI) { if (wr == 1) PG8_BAR; }
    }
    PG8_WAIT_V(0);
    if constexpr (!ALIGN_EPI) { if (wr == 0) PG8_BAR; }
    PG8_BAR;
    if constexpr (Epi::AFTER_DRAIN) { E.fused(acc, cur, wr, wc, fr, fq, lds, wid, lane); S.done(cur); }
#undef PG8_SA
#undef PG8_SB
#undef PG8_STAGE
#undef PG8_LDA
#undef PG8_LDB
#undef PG8_MMA
#undef PG8_WAIT_V
#undef PG8_WAIT_L
#undef PG8_BAR
#undef PG8_SCHED
}
}
namespace att {
#define LAS3 __attribute__((address_space(3)))
typedef unsigned short bf16_t;
typedef short bf16x8 __attribute__((ext_vector_type(8)));
typedef short s16x4 __attribute__((ext_vector_type(4)));
typedef float f32x16 __attribute__((ext_vector_type(16)));
typedef float f32x4 __attribute__((ext_vector_type(4)));
typedef float f32x2_t __attribute__((ext_vector_type(2)));
typedef __bf16 bf16x2_t __attribute__((ext_vector_type(2)));
typedef unsigned u32x4 __attribute__((ext_vector_type(4)));
typedef unsigned u32x2 __attribute__((ext_vector_type(2)));
typedef short v4i16_t __attribute__((ext_vector_type(4)));
constexpr int SEQ = 4096;
constexpr int LDS_SBV = 0;
__device__ __forceinline__ unsigned cvtpk(float lo, float hi) { f32x2_t v = {lo, hi}; bf16x2_t b = __builtin_convertvector(v, bf16x2_t); return __builtin_bit_cast(unsigned, b); }
__device__ __forceinline__ s16x4 vtr(const LAS3 char* p) { return __builtin_bit_cast(s16x4, __builtin_amdgcn_ds_read_tr16_b64_v4i16((LAS3 v4i16_t*)p)); }
__device__ __forceinline__ void glds16(const void* gsrc, unsigned lds_dst) { unsigned keep;
    asm volatile("s_mov_b32 %0, m0\n\ts_mov_b32 m0, %2\n\ts_nop 0\n\tglobal_load_lds_dwordx4 %1, off\n\ts_mov_b32 m0, %0" : "=&s"(keep) : "v"(gsrc), "s"(lds_dst) : "memory"); }
__device__ __forceinline__ float ex2(float x) { return __builtin_amdgcn_exp2f(x); }
__device__ __forceinline__ float lg2(float x) { return __builtin_amdgcn_logf(x); }
#define ATT_MFMA(a, b, c) __builtin_amdgcn_mfma_f32_32x32x16_bf16((a), (b), (c), 0, 0, 0)
#define ATT_VFR(lo, hi) (bf16x8){lo[0], lo[1], lo[2], lo[3], hi[0], hi[1], hi[2], hi[3]}

template <int NQK>
__device__ __forceinline__ void sm_qk(f32x16& p0, f32x16& p1, const bf16x8 (&qf)[NQK], const LAS3 char* ks, const int (&ko)[NQK]) {
    constexpr int H = NQK / 2;
    bf16x8 kf[2][H][2];
#pragma unroll
    for (int j = 0; j < H; ++j) { kf[0][j][0] = *(const LAS3 bf16x8*)(ks + ko[j]); kf[0][j][1] = *(const LAS3 bf16x8*)(ks + ko[j] + (j < 4 ? 4096 : 2048)); }
    __builtin_amdgcn_sched_barrier(0);
#pragma unroll
    for (int j = 0; j < H; ++j) { kf[1][j][0] = *(const LAS3 bf16x8*)(ks + ko[H + j]); kf[1][j][1] = *(const LAS3 bf16x8*)(ks + ko[H + j] + ((H + j) < 4 ? 4096 : 2048)); }
    p0 = f32x16{}; p1 = f32x16{};
#pragma unroll
    for (int j = 0; j < H; ++j) { p0 = ATT_MFMA(kf[0][j][0], qf[j], p0); p1 = ATT_MFMA(kf[0][j][1], qf[j], p1); }
    __builtin_amdgcn_sched_barrier(0);
#pragma unroll
    for (int j = 0; j < H; ++j) { p0 = ATT_MFMA(kf[1][j][0], qf[H + j], p0); p1 = ATT_MFMA(kf[1][j][1], qf[H + j], p1); }
    __builtin_amdgcn_sched_barrier(0);
}
template <int NV>
__device__ __forceinline__ void sm_softmax_pv(f32x16 (&o)[NV], float& m_ref, float& l_run, f32x16& p0, f32x16& p1, const LAS3 char* vb) {
    s16x4 vl[2][NV], vh[2][NV];
#pragma unroll
    for (int d0 = 0; d0 < NV; ++d0) { vl[0][d0] = vtr(vb + d0 * 4096); vh[0][d0] = vtr(vb + d0 * 4096 + 512); }
    float mx = fmaxf(p0[0], p1[0]);
#pragma unroll
    for (int r = 1; r < 16; ++r) mx = fmaxf(fmaxf(mx, p0[r]), p1[r]);
    mx = x32_max(mx);
    if (__any(mx > m_ref + 8.0f)) {
        const float mn = fmaxf(m_ref, mx), alpha = ex2(m_ref - mn); m_ref = mn; l_run *= alpha;
#pragma unroll
        for (int d0 = 0; d0 < NV; ++d0)
#pragma unroll
            for (int r = 0; r < 16; ++r) o[d0][r] *= alpha;
    }
    float s = 0.f;
#pragma unroll
    for (int r = 0; r < 16; ++r) { p0[r] = ex2(p0[r] - m_ref); p1[r] = ex2(p1[r] - m_ref); s += p0[r] + p1[r]; }
    l_run += s;
    u32x4 pw[4];
#pragma unroll
    for (int i = 0; i < 4; ++i) { pw[0][i] = cvtpk(p0[2 * i], p0[2 * i + 1]); pw[1][i] = cvtpk(p0[8 + 2 * i], p0[9 + 2 * i]); pw[2][i] = cvtpk(p1[2 * i], p1[2 * i + 1]); pw[3][i] = cvtpk(p1[8 + 2 * i], p1[9 + 2 * i]); }
    __builtin_amdgcn_sched_barrier(0);
#pragma unroll
    for (int ks = 0; ks < 4; ++ks) {
        if (ks < 3) {
#pragma unroll
            for (int d0 = 0; d0 < NV; ++d0) { vl[(ks + 1) & 1][d0] = vtr(vb + d0 * 4096 + (ks + 1) * 1024); vh[(ks + 1) & 1][d0] = vtr(vb + d0 * 4096 + (ks + 1) * 1024 + 512); } }
#pragma unroll
        for (int d0 = 0; d0 < NV; ++d0) o[d0] = ATT_MFMA(ATT_VFR(vl[ks & 1][d0], vh[ks & 1][d0]), __builtin_bit_cast(bf16x8, pw[ks]), o[d0]);
        __builtin_amdgcn_sched_barrier(0); }
}

template <int NQK, int NV>
__device__ __forceinline__ void sm_pass(f32x16 (&o)[NV], const bf16x8 (&qf)[NQK], int nt_wg, int nt_wave, const bf16_t* k0p, int k0pitch, const bf16_t* k1p, int k1pitch,
                                        const bf16_t* vp, int vpitch, LAS3 char* lds, int wave, int lane) {
    static_assert((NQK == 4 && NV == 4) || (NQK == 6 && NV == 2), "3 DMA instructions per wave per tile");
    constexpr int NKW = (NQK == 4) ? 1 : 2, NVW = NV / 2;
    constexpr int KSLOT = 12288, VSLOT = 16384, VBASE = 3 * KSLOT;
    const int r32 = lane & 31, hi = lane >> 5;
    const LAS3 char* kp = lds;
    const unsigned lds0 = (unsigned)(unsigned long)lds;
    int ko[NQK];
#pragma unroll
    for (int j = 0; j < NQK; ++j) ko[j] = (j < 4) ? r32 * 128 + (((2 * j + hi) ^ ((r32 >> 1) & 7)) * 16) : 8192 + r32 * 64 + (((2 * (j - 4) + hi) ^ ((r32 >> 2) & 3)) * 16);
    const LAS3 char* vb = lds + VBASE + ((lane >> 4) & 1) * 32 + (lane & 3) * 8 + (4 * hi + ((lane & 15) >> 2)) * 64;
    float m_ref = -1e30f, l_run = 0.f;
#pragma unroll
    for (int d0 = 0; d0 < NV; ++d0) o[d0] = f32x16{};
    const int krow0 = 8 * wave + (lane >> 3), krow1 = 16 * (wave & 3) + (lane >> 2);
    const int koff0 = (krow0 * k0pitch + (((lane & 7) ^ ((krow0 >> 1) & 7)) * 8)) * 2, koff1 = (krow1 * k1pitch + (((lane & 3) ^ ((krow1 >> 2) & 3)) * 8)) * 2;
    const int voffl = ((lane >> 2) * vpitch + (lane & 3) * 8) * 2;
#define ATT_DMA_K(t, slot) do { \
        glds16((const char*)k0p + (size_t)(t) * 64 * k0pitch * 2 + koff0, (unsigned)__builtin_amdgcn_readfirstlane((int)(lds0 + (slot) * KSLOT + wave * 1024))); \
        if (NQK == 6) glds16((const char*)k1p + (size_t)(t) * 64 * k1pitch * 2 + koff1, (unsigned)__builtin_amdgcn_readfirstlane((int)(lds0 + (slot) * KSLOT + 8192 + (wave & 3) * 1024))); } while (0)
#define ATT_DMA_V(t, slot) do { _Pragma("unroll") for (int i = 0; i < NVW; ++i) { const int ch = wave + 8 * i; \
        const char* src = (const char*)vp + ((size_t)((t) * 64 + (ch & 3) * 16) * vpitch + (ch >> 2) * 32) * 2 + voffl; \
        glds16(src, (unsigned)__builtin_amdgcn_readfirstlane((int)(lds0 + VBASE + (slot) * VSLOT + ch * 1024))); } } while (0)
#define ATT_WAITBAR(N) asm volatile("s_waitcnt vmcnt(" #N ") lgkmcnt(0)\n\ts_barrier" ::: "memory")
    f32x16 a0, a1, b0, b1;
    ATT_WAITBAR(0);
    ATT_DMA_K(0, 0); ATT_DMA_V(0, 0); ATT_DMA_K(1, 1); ATT_DMA_V(1, 1); ATT_DMA_K(2, 2);
    ATT_WAITBAR(3);
    sm_qk<NQK>(a0, a1, qf, kp, ko);
    int s0 = 0, s1 = 1, s2 = 2;
#define ATT_STEP(tt, C0, C1, N0, N1, QKFIRST) do { \
        if ((tt) + 2 < nt_wg) ATT_WAITBAR(3); else ATT_WAITBAR(0); \
        if ((tt) + 3 < nt_wg) ATT_DMA_K((tt) + 3, s0); \
        if ((tt) + 2 < nt_wg) ATT_DMA_V((tt) + 2, s2); \
        if (QKFIRST) { sm_qk<NQK>(N0, N1, qf, kp + s1 * KSLOT, ko); if ((tt) < nt_wave) sm_softmax_pv<NV>(o, m_ref, l_run, C0, C1, vb + s0 * VSLOT); } \
        else { if ((tt) < nt_wave) sm_softmax_pv<NV>(o, m_ref, l_run, C0, C1, vb + s0 * VSLOT); sm_qk<NQK>(N0, N1, qf, kp + s1 * KSLOT, ko); } \
        { const int s_ = s0; s0 = s1; s1 = s2; s2 = s_; } } while (0)
    if (wave < 4) { for (int t = 0; t < nt_wg; t += 2) { ATT_STEP(t, a0, a1, b0, b1, true); ATT_STEP(t + 1, b0, b1, a0, a1, true); } }
    else          { for (int t = 0; t < nt_wg; t += 2) { ATT_STEP(t, a0, a1, b0, b1, false); ATT_STEP(t + 1, b0, b1, a0, a1, false); } }
#undef ATT_STEP
#undef ATT_DMA_K
#undef ATT_DMA_V
#undef ATT_WAITBAR
    const float l = x32_sum(l_run), inv = 1.0f / l;
#pragma unroll
    for (int d0 = 0; d0 < NV; ++d0)
#pragma unroll
        for (int r = 0; r < 16; ++r) o[d0][r] *= inv;
}

template <int NV, class Pack>
__device__ __forceinline__ void store_rows_staged(bf16_t* dst  , int ldd, LAS3 char* stg, int lane, const Pack& pack) {
    constexpr int ND = 32 * NV, PITCH = 2 * ND + 16, PPR = ND / 8;
    const int r32 = lane & 31, hi = lane >> 5;
#pragma unroll
    for (int d0 = 0; d0 < NV; ++d0)
#pragma unroll
        for (int r4 = 0; r4 < 4; ++r4) *(LAS3 u32x2*)(stg + r32 * PITCH + (32 * d0 + 8 * r4 + 4 * hi) * 2) = pack(d0, r4);
    asm volatile("s_waitcnt lgkmcnt(0)" ::: "memory");
#pragma unroll
    for (int it = 0; it < (32 * PPR) / 64; ++it) { const int idx = it * 64 + lane, row = idx / PPR, c = idx % PPR;
        const u32x4 v = *(const LAS3 u32x4*)(stg + row * PITCH + c * 16); *(u32x4*)(dst + (size_t)row * ldd + c * 8) = v; }
}
__device__ __forceinline__ void diff_unit(int b, int h, int qb, const bf16_t* P, int ldp, bf16_t* MG, const float* subln, float lam, float one_m_li, f32x4* stash  , LAS3 char* lds, int tid, int lane, int w) {
    const int r32 = lane & 31, hi = lane >> 5;
    const size_t row = (size_t)b * SEQ + qb * 256 + w * 32 + r32;
    const bf16_t* Pb = P + (size_t)b * SEQ * ldp;
    const int nt_wg = 4 * qb + 4, nt_wave = 4 * qb + (w >> 1) + 1;
    bf16x8 qf[4]; f32x16 o1[4];
#pragma unroll
    for (int j = 0; j < 4; ++j) qf[j] = *(const bf16x8*)(P + row * ldp + h * 128 + 16 * j + 8 * hi);
    sm_pass<4, 4>(o1, qf, nt_wg, nt_wave, Pb + 512 + h * 128, ldp, Pb, ldp, Pb + 1024 + h * 128, ldp, lds, w, lane);
#pragma unroll
    for (int d0 = 0; d0 < 4; ++d0)
#pragma unroll
        for (int r4 = 0; r4 < 4; ++r4) stash[(d0 * 4 + r4) * 64] = (f32x4){o1[d0][4 * r4], o1[d0][4 * r4 + 1], o1[d0][4 * r4 + 2], o1[d0][4 * r4 + 3]};
#pragma unroll
    for (int j = 0; j < 4; ++j) qf[j] = *(const bf16x8*)(P + row * ldp + h * 128 + 64 + 16 * j + 8 * hi);
    sm_pass<4, 4>(o1, qf, nt_wg, nt_wave, Pb + 512 + h * 128 + 64, ldp, Pb, ldp, Pb + 1024 + h * 128, ldp, lds, w, lane);
    float ss = 0.f;
#pragma unroll
    for (int d0 = 0; d0 < 4; ++d0)
#pragma unroll
        for (int r4 = 0; r4 < 4; ++r4) { const f32x4 a1 = stash[(d0 * 4 + r4) * 64];
#pragma unroll
            for (int e = 0; e < 4; ++e) { const float y = a1[e] - lam * o1[d0][4 * r4 + e]; o1[d0][4 * r4 + e] = y; ss += y * y; } }
    ss = x32_sum(ss);
    const float rn = one_m_li / sqrtf(ss * (1.0f / 128.0f) + 1e-6f);
    asm volatile("s_waitcnt lgkmcnt(0)\n\ts_barrier" ::: "memory");
    store_rows_staged<4>(MG + (row - r32) * 1024 + h * 128, 1024, lds + w * 8704, lane, [&](int d0, int r4) { const int d = 32 * d0 + 8 * r4 + 4 * hi; const f32x4 g = *(const f32x4*)(subln + d);
        u32x2 wv; wv.x = cvtpk(o1[d0][4 * r4] * rn * g[0], o1[d0][4 * r4 + 1] * rn * g[1]); wv.y = cvtpk(o1[d0][4 * r4 + 2] * rn * g[2], o1[d0][4 * r4 + 3] * rn * g[3]); return wv; });
}
__device__ __forceinline__ void mla_unit(int b, int h, int qb, const bf16_t* P, int ldp, const bf16_t* QB, const bf16_t* KV, bf16_t* MG, LAS3 char* lds, int tid, int lane, int w) {
    const int r32 = lane & 31, hi = lane >> 5;
    const size_t row = (size_t)b * SEQ + qb * 256 + w * 32 + r32;
    const bf16_t* Pb = P + (size_t)b * SEQ * ldp; const bf16_t* KVb = KV + (size_t)b * SEQ * 512;
    const int nt_wg = 4 * qb + 4, nt_wave = 4 * qb + (w >> 1) + 1;
    bf16x8 qf[6]; f32x16 o[2];
#pragma unroll
    for (int j = 0; j < 6; ++j) qf[j] = *(const bf16x8*)(QB + row * 512 + h * 128 + 16 * j + 8 * hi);
    sm_pass<6, 2>(o, qf, nt_wg, nt_wave, KVb + h * 128, 512, Pb + 1920, ldp, KVb + h * 128 + 64, 512, lds, w, lane);
    asm volatile("s_waitcnt lgkmcnt(0)\n\ts_barrier" ::: "memory");
    store_rows_staged<2>(MG + (row - r32) * 1024 + 512 + h * 64, 1024, lds + w * 4608, lane, [&](int d0, int r4) {
        u32x2 wv; wv.x = cvtpk(o[d0][4 * r4], o[d0][4 * r4 + 1]); wv.y = cvtpk(o[d0][4 * r4 + 2], o[d0][4 * r4 + 3]); return wv; });
}
constexpr float SB_STOP = 152.0f;
__device__ __forceinline__ void sb_unit(int b, int h, int qb32, const bf16_t* P, int ldp, bf16_t* MG, LAS3 char* vl, int lane) {
    const int r32 = lane & 31, hi = lane >> 5;
    const size_t row = (size_t)b * SEQ + qb32 * 32 + r32;
    const bf16_t* Pb = P + (size_t)b * SEQ * ldp;
    const int T = qb32 >> 1, qrel = (qb32 & 1) * 32 + r32;
    bf16x8 qf[4]; f32x16 o[2]; o[0] = f32x16{}; o[1] = f32x16{};
#pragma unroll
    for (int j = 0; j < 4; ++j) qf[j] = *(const bf16x8*)(P + row * ldp + 2048 + h * 64 + 16 * j + 8 * hi);
    const LAS3 char* vb = vl + ((lane >> 4) & 1) * 32 + (lane & 3) * 8 + (4 * hi + ((lane & 15) >> 2)) * 64;
    float R = 0.f;
    const int voffs = ((lane >> 3) * ldp + 2560 + h * 64 + (lane & 7) * 8) * 2;
    const int koffs = (r32 * ldp + 2304 + h * 64 + 8 * hi) * 2;
    u32x4 vr[8]; bf16x8 kf[4][2];
#define SB_FETCH(tt) do { const char* kt_ = (const char*)(Pb + (size_t)((tt) * 64) * ldp); \
        _Pragma("unroll") for (int it = 0; it < 8; ++it) vr[it] = *(const u32x4*)(kt_ + (size_t)(8 * it) * ldp * 2 + voffs); \
        _Pragma("unroll") for (int j = 0; j < 4; ++j) { kf[j][0] = *(const bf16x8*)(kt_ + koffs + 32 * j); kf[j][1] = *(const bf16x8*)(kt_ + (size_t)32 * ldp * 2 + koffs + 32 * j); } } while (0)
    SB_FETCH(T);
    for (int t = T; t >= 0; --t) {
        f32x16 p0 = {}, p1 = {};
#pragma unroll
        for (int j = 0; j < 4; ++j) { p0 = ATT_MFMA(kf[j][0], qf[j], p0); p1 = ATT_MFMA(kf[j][1], qf[j], p1); }
        asm volatile("s_waitcnt lgkmcnt(0)" ::: "memory");
#pragma unroll
        for (int it = 0; it < 8; ++it) { const int idx = it * 64 + lane, key = idx >> 3, c8 = idx & 7; *(LAS3 u32x4*)(vl + (c8 >> 2) * 4096 + key * 64 + (c8 & 3) * 16) = vr[it]; }
        if (t > 0) SB_FETCH(t - 1);
        const bool diag = (t == T);
        f32x16 s0, s1;
#pragma unroll
        for (int r = 0; r < 16; ++r) { const int kk = (r & 3) + 8 * (r >> 2) + 4 * hi;
            const float z0 = p0[r], z1 = p1[r];
            float a0 = fmaxf(z0, 0.f) + lg2(1.0f + ex2(-fabsf(z0))), a1 = fmaxf(z1, 0.f) + lg2(1.0f + ex2(-fabsf(z1)));
            if (diag && !(kk < qrel)) a0 = 0.f;
            if (diag && !(kk + 32 < qrel)) a1 = 0.f;
            s0[r] = a0; s1[r] = a1; }
        float own[8], oth[8];
#pragma unroll
        for (int i = 0; i < 4; ++i) { own[i] = (s0[4 * i] + s0[4 * i + 1]) + (s0[4 * i + 2] + s0[4 * i + 3]); own[4 + i] = (s1[4 * i] + s1[4 * i + 1]) + (s1[4 * i + 2] + s1[4 * i + 3]); }
#pragma unroll
        for (int i = 0; i < 8; ++i) oth[i] = x32_other(own[i], hi);
        float Aown[8]; float run = 0.f;
#pragma unroll
        for (int i = 7; i >= 0; --i) { const float Se = hi ? oth[i] : own[i], So = hi ? own[i] : oth[i];
            const float A_odd = run; run += So; const float A_even = run; run += Se;
            Aown[i] = hi ? A_odd : A_even; }
        const float tile_sum = run;
#pragma unroll
        for (int i = 0; i < 4; ++i) {
            float af0 = Aown[i] + R, af1 = Aown[4 + i] + R;
#pragma unroll
            for (int e = 3; e >= 0; --e) { const int r = 4 * i + e; const int kk = e + 8 * i + 4 * hi;
                const float sp0 = s0[r], sp1 = s1[r];
                float w0 = ex2(p0[r] - sp0 - af0), w1 = ex2(p1[r] - sp1 - af1);
                if (diag && !(kk < qrel)) w0 = 0.f;
                if (diag && !(kk + 32 < qrel)) w1 = 0.f;
                af0 += sp0; af1 += sp1; p0[r] = w0; p1[r] = w1; } }
        R += tile_sum;
        u32x4 pw[4];
#pragma unroll
        for (int i = 0; i < 4; ++i) { pw[0][i] = cvtpk(p0[2 * i], p0[2 * i + 1]); pw[1][i] = cvtpk(p0[8 + 2 * i], p0[9 + 2 * i]); pw[2][i] = cvtpk(p1[2 * i], p1[2 * i + 1]); pw[3][i] = cvtpk(p1[8 + 2 * i], p1[9 + 2 * i]); }
        asm volatile("s_waitcnt lgkmcnt(0)" ::: "memory");
#pragma unroll
        for (int d0 = 0; d0 < 2; ++d0)
#pragma unroll
            for (int ks = 0; ks < 4; ++ks) { const s16x4 lo = vtr(vb + d0 * 4096 + ks * 1024), hi4 = vtr(vb + d0 * 4096 + ks * 1024 + 512);
                o[d0] = ATT_MFMA(ATT_VFR(lo, hi4), __builtin_bit_cast(bf16x8, pw[ks]), o[d0]); }
        if (__all(R >= SB_STOP)) break;
    }
#undef SB_FETCH
    asm volatile("s_waitcnt lgkmcnt(0)" ::: "memory");
    store_rows_staged<2>(MG + (row - r32) * 1024 + 768 + h * 64, 1024, vl, lane, [&](int d0, int r4) {
        u32x2 wv; wv.x = cvtpk(o[d0][4 * r4], o[d0][4 * r4 + 1]); wv.y = cvtpk(o[d0][4 * r4 + 2], o[d0][4 * r4 + 3]); return wv; });
}
}
#define LAS __attribute__((address_space(3)))
typedef unsigned short bf16;
typedef unsigned v4u __attribute__((ext_vector_type(4)));
typedef float f32x4 __attribute__((ext_vector_type(4)));
constexpr int NWAVES = 8;
constexpr int BATCH = 8, SEQ = 4096, D = 1024, M = BATCH * SEQ, DFF = 2816, DEPTH = 2;
constexpr int NIN = 2816  , IN_SRC = 2720;
constexpr size_t MiB = 1u << 20;
constexpr size_t WS_COSD = 1 * MiB, WS_SIND = WS_COSD + 128 * 1024, WS_COSM = WS_SIND + 128 * 1024, WS_SINM = WS_COSM + 256 * 1024;
constexpr size_t WS_PART = 2 * MiB;
constexpr size_t WS_PARTQ = 4 * MiB;
constexpr size_t WS_PARTKV = 4 * MiB + 512 * 1024;
constexpr size_t WS_W = 8 * MiB, WS_WL = 42 * MiB;
constexpr size_t W_GU1 = 0, W_D1 = 11 * MiB, W_IN = W_D1 + 5632 * 1024, W_UQ = W_IN + 5632 * 1024, W_UKV = W_UQ + 256 * 1024, W_OUT = W_UKV + 256 * 1024, W_GU2 = W_OUT + 2 * MiB, W_D2 = W_GU2 + 11 * MiB;
static_assert(W_D2 + 5632 * 1024 <= WS_WL, "weight map");
constexpr size_t WS_XB = 96 * MiB;
constexpr size_t WS_MG = 160 * MiB;
constexpr size_t WS_QB = 224 * MiB;
constexpr size_t WS_KV = 256 * MiB;
constexpr size_t WS_HP = 288 * MiB;
constexpr size_t WS_STASH = 464 * MiB;
constexpr size_t WS_END = 496 * MiB;
constexpr int RING_BYTES = 131072, LDS_BYTES = 147456;

__device__ __forceinline__ unsigned f2bf(float f) { unsigned u = __builtin_bit_cast(unsigned, f); return (u + 0x7fffu + ((u >> 16) & 1u)) >> 16; }
__device__ __forceinline__ unsigned pk2(float lo, float hi) { return f2bf(lo) | (f2bf(hi) << 16); }
__device__ __forceinline__ int ropeperm(int p, int half) { return ((p >> 2) & 1) * half + 4 * (p >> 3) + (p & 3); }
__device__ __forceinline__ int src_col(int kind, int n, int nsrc, int& mat) {
    mat = 0;
    if (kind == 0) return n < nsrc ? n : -1;
    if (kind == 1) { const int pn = n >> 8, w = n & 255; mat = w >> 7; return pn * 128 + (w & 127); }
    if (kind == 2) { const int tile = n >> 8, w = n & 255;
        if (tile < 4) { const int d = n & 63; return d < 16 ? (n & ~63) + ropeperm(d, 8) : n; }
        if (tile < 7) return n;
        if (tile == 7) { if (w < 128) return 1792 + w; if (w < 160) return 1920 + ropeperm(w - 128, 16); return -1; }
        return n - 96; }
    { const int head = n >> 7, w = n & 127; if (w < 64) return head * 96 + w; if (w < 96) return head * 96 + 64 + ropeperm(w - 64, 16); return -1; }
}
__device__ __forceinline__ void wt_item(const float* W0, const float* W1, const float* gain, bf16* WT, int Ksrc, int Kdst, int Nsrc, int Ndst, int kind, LAS float* scr  , int item, int lane) {
    const int nblk = Ndst / 64, kb = item / nblk, nb = item % nblk, k0 = 64 * kb, n0 = 64 * nb;
    int mat; const int sc = src_col(kind, n0 + lane, Nsrc, mat); const float* W = mat ? W1 : W0;
    const bool live = (sc >= 0) && (k0 < Ksrc);
    const float* wp = W + (size_t)k0 * Nsrc + (live ? sc : 0);
#pragma unroll 16
    for (int kk = 0; kk < 64; ++kk) { float v = 0.f; if (live) v = wp[(size_t)kk * Nsrc]; scr[kk * 65 + lane] = v; }
    asm volatile("s_waitcnt lgkmcnt(0)" ::: "memory");
    const int c = lane & 7;
    f32x4 g0 = {1.f, 1.f, 1.f, 1.f}, g1 = {1.f, 1.f, 1.f, 1.f};
    if (gain && k0 < Ksrc) { g0 = *(const f32x4*)(gain + k0 + 8 * c); g1 = *(const f32x4*)(gain + k0 + 8 * c + 4); }
#pragma unroll
    for (int j = 0; j < 8; ++j) { const int n = (lane >> 3) + 8 * j; const LAS float* s = scr + (8 * c) * 65 + n;
        v4u o; o.x = pk2(s[0 * 65] * g0[0], s[1 * 65] * g0[1]); o.y = pk2(s[2 * 65] * g0[2], s[3 * 65] * g0[3]); o.z = pk2(s[4 * 65] * g1[0], s[5 * 65] * g1[1]); o.w = pk2(s[6 * 65] * g1[2], s[7 * 65] * g1[3]);
        *(v4u*)(WT + (size_t)(n0 + n) * Kdst + k0 + 8 * c) = o; }
    asm volatile("s_waitcnt lgkmcnt(0)" ::: "memory");
}
__device__ __forceinline__ void wt_tile(const float* W0, const float* W1, const float* gain, bf16* WT, int Ksrc, int Kdst, int Nsrc, int Ndst, int kind, LAS float* img, int tile, int wave, int lane) {
    constexpr int S = 260;
    const int nblk = Ndst / 256, kb = tile / nblk, nb = tile % nblk, k0 = 128 * kb, n0 = 256 * nb;
    int mat; const int sc = src_col(kind, n0 + 4 * lane, Nsrc, mat); const float* W = mat ? W1 : W0;
    const bool live = (sc >= 0) && (k0 < Ksrc);
    const float* wp = W + (size_t)(k0 + wave) * Nsrc + (live ? sc : 0);
    f32x4 v[16];
#pragma unroll
    for (int i = 0; i < 16; ++i) v[i] = live ? __builtin_nontemporal_load((const f32x4*)(wp + (size_t)(8 * i) * Nsrc)) : (f32x4){0.f, 0.f, 0.f, 0.f};
#pragma unroll
    for (int i = 0; i < 16; ++i) { const int kl = wave + 8 * i; const float g = (gain && k0 < Ksrc) ? gain[k0 + kl] : 1.0f; *(LAS f32x4*)(img + kl * S + 4 * lane) = v[i] * g; }
    __syncthreads();
    const int c = lane & 15, nsub = lane >> 4;
#pragma unroll
    for (int j = 0; j < 8; ++j) { const int n = 32 * j + 4 * wave + nsub; const LAS float* s = img + (8 * c) * S + n;
        v4u o; o.x = pk2(s[0 * S], s[1 * S]); o.y = pk2(s[2 * S], s[3 * S]); o.z = pk2(s[4 * S], s[5 * S]); o.w = pk2(s[6 * S], s[7 * S]);
        *(v4u*)(WT + (size_t)(n0 + n) * Kdst + k0 + 8 * c) = o; }
    __syncthreads();
}
__device__ __forceinline__ void sincos_d(float af, float& c, float& s) {
    const double a = (double)af; const double TWO_PI = 6.283185307179586476925287, INV_2PI = 0.15915494309189533576888;
    const double n = rint(a * INV_2PI); double r = a - n * TWO_PI;
    r *= 0.25; const double r2 = r * r;
    double sn = r * (1.0 + r2 * (-1.0 / 6 + r2 * (1.0 / 120 + r2 * (-1.0 / 5040 + r2 * (1.0 / 362880 + r2 * (-1.0 / 39916800 + r2 * (1.0 / 6227020800.0)))))));
    double cs = 1.0 + r2 * (-0.5 + r2 * (1.0 / 24 + r2 * (-1.0 / 720 + r2 * (1.0 / 40320 + r2 * (-1.0 / 3628800 + r2 * (1.0 / 479001600.0 + r2 * (-1.0 / 87178291200.0)))))));
#pragma unroll
    for (int i = 0; i < 2; ++i) { const double s2 = 2.0 * sn * cs, c2 = cs * cs - sn * sn; sn = s2; cs = c2; }
    c = (float)cs; s = (float)sn;
}

typedef __attribute__((address_space(1))) unsigned gu32;
#define XB_TMO      128
#define XB_XCNT(j)  (256  + 64 * (j))
#define XB_XSUB(j)  (1280 + 64 * (j))
#define XB_XGEN(j)  (2304 + 64 * (j))
#define XB_TOP      3328
#define XB_TOPGEN   3392
#define XCD_BAR_WORDS 3456
#define XB_SPIN_CAP (1u << 18)

__device__ __forceinline__ unsigned xb_ld(unsigned* p)              { return __hip_atomic_load(p, __ATOMIC_RELAXED, __HIP_MEMORY_SCOPE_AGENT); }
__device__ __forceinline__ unsigned xb_add(unsigned* p, unsigned v) { return __hip_atomic_fetch_add(p, v, __ATOMIC_RELAXED, __HIP_MEMORY_SCOPE_AGENT); }
__device__ __forceinline__ unsigned xb_xcc_id() { return (unsigned)__builtin_amdgcn_s_getreg((3 << 11) | 20) & 0xFu; }
#define XB_SPIN(cond, bar) do { unsigned _sp = 0; while (cond) { __builtin_amdgcn_s_sleep(1); \
    if ((++_sp & 255u) == 0u) { if (xb_ld(&(bar)[XB_TMO])) break; if (_sp > XB_SPIN_CAP) { atomicAdd(&(bar)[XB_TMO], 1u); break; } } } } while (0)

struct XcdBarrier {
    unsigned* bar; unsigned x;
    volatile LAS unsigned* st;
};

__device__ __forceinline__ XcdBarrier xcd_barrier_post(unsigned* bar, volatile LAS unsigned* st, bool leader) {
    XcdBarrier b; b.bar = bar; b.x = xb_xcc_id(); b.st = st;
    if (leader) (void)xb_add(&bar[XB_XCNT(b.x)], 1u);
    return b;
}
__device__ __forceinline__ void xcd_barrier_complete(unsigned* bar, unsigned x, unsigned& nloc, unsigned& nx) {
    const unsigned G = gridDim.x * gridDim.y * gridDim.z;
    unsigned sum, cnt, mine, sp = 0u;
    for (;;) {
        sum = 0u; cnt = 0u; mine = 0u;
#pragma unroll
        for (unsigned j = 0; j < 16; ++j) { const unsigned c = xb_ld(&bar[XB_XCNT(j)]); sum += c; cnt += (c > 0u) ? 1u : 0u; mine = (j == x) ? c : mine; }
        if (sum == G) break;
        __builtin_amdgcn_s_sleep(1);
        if ((++sp & 255u) == 0u) { if (xb_ld(&bar[XB_TMO])) break; if (sp > XB_SPIN_CAP) { atomicAdd(&bar[XB_TMO], 1u); break; } }
    }
    nloc = mine > 0u ? mine : 1u; nx = cnt > 0u ? cnt : 1u;
}

__device__ __forceinline__ void xcd_barrier(const XcdBarrier& b, bool leader) {
    asm volatile("s_waitcnt vmcnt(0)" ::: "memory");
    __syncthreads();
    if (leader) {
        unsigned* bar = b.bar;
        __builtin_amdgcn_s_waitcnt(0);
        unsigned nloc = b.st[0], nx = b.st[1];
        if (nloc == 0u) { xcd_barrier_complete(bar, b.x, nloc, nx); b.st[0] = nloc; b.st[1] = nx; }
        const unsigned old = xb_add(&bar[XB_XSUB(b.x)], 1u);
        const unsigned gen = old / nloc;
        if (old + 1u == (gen + 1u) * nloc) {
            __builtin_amdgcn_fence(__ATOMIC_RELEASE, "agent");
            asm volatile("s_waitcnt vmcnt(0)" ::: "memory");
            const unsigned og = xb_add(&bar[XB_TOP], 1u);
            const unsigned tg = og / nx;
            if (og + 1u == (tg + 1u) * nx) xb_add(&bar[XB_TOPGEN], 1u);
            else XB_SPIN(xb_ld(&bar[XB_TOPGEN]) == tg, bar);
            __builtin_amdgcn_fence(__ATOMIC_ACQUIRE, "agent");
            xb_add(&bar[XB_XGEN(b.x)], 1u);
            asm volatile("s_waitcnt vmcnt(0)" ::: "memory");
        } else {
            XB_SPIN(xb_ld(&bar[XB_XGEN(b.x)]) == gen, bar);
            __builtin_amdgcn_fence(__ATOMIC_ACQUIRE, "agent");
            asm volatile("s_waitcnt vmcnt(0)" ::: "memory");
        }
    }
    __syncthreads();
}


struct Args { const float* in[22]; float* out; unsigned char* ws; };

__global__ void __launch_bounds__(NWAVES * 64, 2) fwd_mega(Args a) {
    extern __shared__ __attribute__((aligned(16))) unsigned char lds_raw[];
    cg::grid_group grid = cg::this_grid();
    LAS unsigned char* lds = (LAS unsigned char*)lds_raw;
    const int wave = __builtin_amdgcn_readfirstlane((int)threadIdx.x >> 6);
#define FRESH_LANE() ({ unsigned m_ = ~0u; asm volatile("" : "+s"(m_)); int l_ = (int)__builtin_amdgcn_mbcnt_hi(m_, __builtin_amdgcn_mbcnt_lo(m_, 0u)); l_; })
    volatile LAS unsigned* MISC = (volatile LAS unsigned*)(lds + RING_BYTES + 15360);
    { const int ln0 = FRESH_LANE(); if (wave == 0 && ln0 < 2) MISC[ln0] = 0u;
      if (blockIdx.x == 0) { unsigned* bw = (unsigned*)a.ws; for (int i = wave * 64 + ln0; i < XCD_BAR_WORDS; i += NWAVES * 64) bw[i] = 0u; } }
    __syncthreads();
    const int G = gridDim.x, bx = blockIdx.x; const int vcu = (G % 8 == 0) ? (bx % 8) * (G / 8) + bx / 8 : bx;
#define LOCALS() \
    int z_ = 0; asm volatile("" : "+s"(z_)); const float* const* in = a.in + z_; \
    unsigned char* ws = a.ws + z_; float* out = a.out + z_; const float* x = in[0]; \
    float* cosd = (float*)(ws + WS_COSD); float* sind = (float*)(ws + WS_SIND); float* cosm = (float*)(ws + WS_COSM); float* sinm = (float*)(ws + WS_SINM); \
    float* part = (float*)(ws + WS_PART); float* partq = (float*)(ws + WS_PARTQ); float* partkv = (float*)(ws + WS_PARTKV); \
    bf16* XB = (bf16*)(ws + WS_XB); bf16* MG = (bf16*)(ws + WS_MG); bf16* QB = (bf16*)(ws + WS_QB); bf16* KV = (bf16*)(ws + WS_KV); bf16* HP = (bf16*)(ws + WS_HP); \
    (void)x; (void)out; (void)cosd; (void)sind; (void)cosm; (void)sinm; (void)part; (void)partq; (void)partkv; (void)XB; (void)MG; (void)QB; (void)KV; (void)HP
    const int gw = vcu * NWAVES + wave, NGW = G * NWAVES;

    {
        LOCALS();
        const int lane = FRESH_LANE(), tid = wave * 64 + lane;
        LAS float* scr = (LAS float*)(lds + wave * 16640);
        constexpr int I_GU = 16 * 88, I_D = 44 * 16, I_IN = 16 * 44, I_UQ = 4 * 8, I_UKV = 4 * 8, I_OUT = 16 * 16;
        constexpr int I_LAYER = 2 * I_GU + 2 * I_D + I_IN + I_UQ + I_UKV + I_OUT;
        constexpr int T_GU = 8 * 22, T_D = 22 * 4, T_IN = 8 * 11, T_UQ = 2 * 2, T_UKV = 2 * 2, T_OUT = 8 * 4, T_LAYER = 2 * T_GU + 2 * T_D + T_IN + T_UQ + T_UKV + T_OUT;
        LAS float* img = (LAS float*)lds;
        for (int tl = vcu; tl < DEPTH * T_LAYER; tl += G) {
            const int l = tl / T_LAYER; int r = tl % T_LAYER; bf16* wl = (bf16*)(ws + WS_W + l * WS_WL);
            if (r < T_GU) { wt_tile(in[2] + (size_t)l * D * DFF, in[3] + (size_t)l * D * DFF, in[1] + l * D, (bf16*)((char*)wl + W_GU1), D, D, DFF, 2 * DFF, 1, img, r, wave, lane); continue; } r -= T_GU;
            if (r < T_D) { wt_tile(in[4] + (size_t)l * DFF * D, nullptr, nullptr, (bf16*)((char*)wl + W_D1), DFF, DFF, D, D, 0, img, r, wave, lane); continue; } r -= T_D;
            if (r < T_IN) { wt_tile(in[6] + (size_t)l * D * IN_SRC, nullptr, in[5] + l * D, (bf16*)((char*)wl + W_IN), D, D, IN_SRC, NIN, 2, img, r, wave, lane); continue; } r -= T_IN;
            if (r < T_UQ) { wt_tile(in[13] + (size_t)l * 256 * 384, nullptr, in[12] + l * 256, (bf16*)((char*)wl + W_UQ), 256, 256, 384, 512, 3, img, r, wave, lane); continue; } r -= T_UQ;
            if (r < T_UKV) { wt_tile(in[15] + (size_t)l * 128 * 512, nullptr, in[14] + l * 128, (bf16*)((char*)wl + W_UKV), 128, 256, 512, 512, 0, img, r, wave, lane); continue; } r -= T_UKV;
            if (r < T_OUT) { wt_tile(in[16] + (size_t)l * D * D, nullptr, nullptr, (bf16*)((char*)wl + W_OUT), D, D, D, D, 0, img, r, wave, lane); continue; } r -= T_OUT;
            if (r < T_GU) { wt_tile(in[18] + (size_t)l * D * DFF, in[19] + (size_t)l * D * DFF, in[17] + l * D, (bf16*)((char*)wl + W_GU2), D, D, DFF, 2 * DFF, 1, img, r, wave, lane); continue; } r -= T_GU;
            wt_tile(in[20] + (size_t)l * DFF * D, nullptr, nullptr, (bf16*)((char*)wl + W_D2), DFF, DFF, D, D, 0, img, r, wave, lane);
        }
        for (int i = bx * 512 + tid; i < SEQ * 24; i += G * 512) {
            const int pos = i / 24, k = i % 24; float c, s;
            if (k < 8) { const float inv = (float)exp2(-(double)(2 * k) / 16.0 * 18.931568569324174  ); sincos_d((float)pos * inv, c, s); cosd[pos * 8 + k] = c; sind[pos * 8 + k] = s; }
            else { const int kk = k - 8; const float inv = (float)exp2(-(double)(2 * kk) / 32.0 * 18.931568569324174); sincos_d((float)pos * inv, c, s); cosm[pos * 16 + kk] = c; sinm[pos * 16 + kk] = s; }
        }
        for (int m0 = gw * 4; m0 < M; m0 += NGW * 4) {
            f32x4 v[4][4]; float s[4];
#pragma unroll
            for (int r = 0; r < 4; ++r) { const f32x4* xr = (const f32x4*)(x + (size_t)(m0 + r) * D) + lane;
#pragma unroll
                for (int j = 0; j < 4; ++j) v[r][j] = __builtin_nontemporal_load(xr + 64 * j); }
#pragma unroll
            for (int r = 0; r < 4; ++r) { float t = 0.f;
#pragma unroll
                for (int j = 0; j < 4; ++j) t += (v[r][j].x * v[r][j].x + v[r][j].y * v[r][j].y) + (v[r][j].z * v[r][j].z + v[r][j].w * v[r][j].w);
                s[r] = wave_sum(t); }
#pragma unroll
            for (int r = 0; r < 4; ++r) { unsigned long long* o8 = (unsigned long long*)(XB + (size_t)(m0 + r) * D) + lane;
#pragma unroll
                for (int j = 0; j < 4; ++j) o8[64 * j] = (unsigned long long)pk2(v[r][j].x, v[r][j].y) | ((unsigned long long)pk2(v[r][j].z, v[r][j].w) << 32); }
            { const int r = lane >> 4, c = lane & 15; const float sv = r == 0 ? s[0] : r == 1 ? s[1] : r == 2 ? s[2] : s[3]; part[(size_t)(m0 + r) * 16 + c] = c == 0 ? sv : 0.f; }
        }
    }
    grid.sync();
    XcdBarrier bar = xcd_barrier_post((unsigned*)a.ws, MISC, wave == 0 && FRESH_LANE() == 0);

    const float QS64 = 0.125f * 1.4426950408889634f, QS96 = 0.10206207261596575f * 1.4426950408889634f;
    for (int st = 0; st < DEPTH * 8; ++st) {
        LOCALS();
        const int l = st >> 3, k = st & 7;
        const unsigned char* wl = ws + WS_W + (size_t)l * WS_WL;
        if (0) {}
#ifndef NO_UP
        else if (k == 0 || k == 6) {
            pg8::Gemm g{XB, (const bf16*)(wl + (k == 0 ? W_GU1 : W_GU2)), M, 2 * DFF, D, D, D}; pg8::StaticOrder S; S.init(M, 2 * DFF, G, bx);
            LAS float* rst = (LAS float*)(lds + RING_BYTES); pg8::fill_rowscale<16>(rst, S, part, 1.0f / 1024.0f, 1.0f, wave * 64 + FRESH_LANE());
            pg8::EpiUp E{HP, rst, DFF};
            pg8::gemm_phase<pg8::EpiUp, pg8::StaticOrder, true, true>(lds, g, S, E, wave);
        }
#endif
#ifndef NO_RES
        else if (k == 1 || k == 7 || k == 5) {
            const bool wo = (k == 5);
            pg8::Gemm g{wo ? MG : HP, (const bf16*)(wl + (k == 1 ? W_D1 : k == 7 ? W_D2 : W_OUT)), M, D, wo ? D : DFF, wo ? D : DFF, wo ? D : DFF}; pg8::StaticOrder S; S.init(M, D, G, bx);
            pg8::EpiRes E{XB, part, wo ? 1.0f : 0.5f};
            pg8::gemm_phase<pg8::EpiRes, pg8::StaticOrder, true, true>(lds, g, S, E, wave);
        }
#endif
#ifndef NO_IN
        else if (k == 2) {
            pg8::Gemm g{XB, (const bf16*)(wl + W_IN), M, NIN, D, D, D}; pg8::StaticOrder S; S.init(M, NIN, G, bx);
            LAS float* rst = (LAS float*)(lds + RING_BYTES); pg8::fill_rowscale<16>(rst, S, part, 1.0f / 1024.0f, 1.0f, wave * 64 + FRESH_LANE());
            pg8::EpiIn E{HP, rst, partq, partkv, cosd, sind, cosm, sinm, NIN, QS64};
            pg8::gemm_phase<pg8::EpiIn, pg8::StaticOrder, true, true>(lds, g, S, E, wave);
        }
#endif
#ifndef NO_MLA
        else if (k == 3) {
            { pg8::Gemm g{HP + 6 * 256, (const bf16*)(wl + W_UQ), M, 512, 256, NIN, 256}; pg8::StaticOrder S; S.init(M, 512, G, bx);
              LAS float* rst = (LAS float*)(lds + RING_BYTES); pg8::fill_rowscale<4>(rst, S, partq, 1.0f / 256.0f, QS96, wave * 64 + FRESH_LANE());
              pg8::EpiMla<true> E{QB, rst, cosm, sinm, 512};
              pg8::gemm_phase<pg8::EpiMla<true>, pg8::StaticOrder, true, true>(lds, g, S, E, wave); }
            { pg8::Gemm g{HP + 7 * 256, (const bf16*)(wl + W_UKV), M, 512, 256, NIN, 256}; pg8::StaticOrder S; S.init(M, 512, G, bx);
              LAS float* rst = (LAS float*)(lds + RING_BYTES) + 1024; pg8::fill_rowscale<4>(rst, S, partkv, 1.0f / 128.0f, 1.0f, wave * 64 + FRESH_LANE());
              pg8::EpiMla<false> E{KV, rst, cosm, sinm, 512};
              pg8::gemm_phase<pg8::EpiMla<false>, pg8::StaticOrder, true, true>(lds, g, S, E, wave); }
        }
#endif
#ifndef NO_ATT
        else {
            const float li = 0.8f - 0.6f * expf(-0.3f * (float)l);
            const int lane = FRESH_LANE();
            float v1 = in[7][l * 64 + lane] * in[8][l * 64 + lane], v2 = in[9][l * 64 + lane] * in[10][l * 64 + lane];
            v1 = wave_sum(v1); v2 = wave_sum(v2);
            const float lam = expf(v1) - expf(v2) + li;
            const float* subln = in[11] + l * 128;
            for (int pr = vcu; pr < 256; pr += G) { const int bh = pr >> 3, s = pr & 7, b = bh >> 2, h = bh & 3;
#ifndef NO_DIFF
#pragma clang loop unroll(disable)
                for (int rep = 0; rep < 2; ++rep) { const int ln = FRESH_LANE();
                    f32x4* stash = (f32x4*)(ws + WS_STASH) + ((size_t)(bx * NWAVES + wave) * 16) * 64 + ln;
                    att::diff_unit(b, h, rep ? 15 - s : s, HP, NIN, MG, subln, lam, 1.0f - li, stash, (LAS char*)lds, wave * 64 + ln, ln, wave); }
#endif
#ifndef NO_MLAU
#pragma clang loop unroll(disable)
                for (int rep = 0; rep < 2; ++rep) { const int ln = FRESH_LANE();
                    att::mla_unit(b, h, rep ? 15 - s : s, HP, NIN, QB, KV, MG, (LAS char*)lds, wave * 64 + ln, ln, wave); }
#endif
            }
            __syncthreads();
#ifndef NO_SB
#pragma clang loop unroll(disable)
            for (int u = bx * NWAVES + wave; u < BATCH * 4 * 128; u += NGW) { const int b = u >> 9, h = (u >> 7) & 3, qb32 = u & 127; const int ln = FRESH_LANE();
                att::sb_unit(b, h, qb32, HP, NIN, MG, (LAS char*)lds + att::LDS_SBV + wave * 8192, ln); }
#endif
            __syncthreads();
        }
#endif
        xcd_barrier(bar, wave == 0 && FRESH_LANE() == 0);
    }
    {
        LOCALS();
        const int lane = FRESH_LANE();
        const float* gn = in[21];
        f32x4 g4[2][2];
#pragma unroll
        for (int j = 0; j < 2; ++j) { g4[j][0] = *(const f32x4*)(gn + 8 * lane + 512 * j); g4[j][1] = *(const f32x4*)(gn + 8 * lane + 512 * j + 4); }
        for (int m0 = gw * 4; m0 < M; m0 += NGW * 4) {
            v4u raw[4][2];
#pragma unroll
            for (int r = 0; r < 4; ++r)
#pragma unroll
                for (int j = 0; j < 2; ++j) raw[r][j] = *(const v4u*)(XB + (size_t)(m0 + r) * D + 8 * lane + 512 * j);
#pragma unroll
            for (int r = 0; r < 4; ++r) { f32x4 v[2][2]; float t = 0.f;
#pragma unroll
                for (int j = 0; j < 2; ++j) { const v4u w = raw[r][j];
                    v[j][0] = (f32x4){__builtin_bit_cast(float, w.x << 16), __builtin_bit_cast(float, w.x & 0xffff0000u), __builtin_bit_cast(float, w.y << 16), __builtin_bit_cast(float, w.y & 0xffff0000u)};
                    v[j][1] = (f32x4){__builtin_bit_cast(float, w.z << 16), __builtin_bit_cast(float, w.z & 0xffff0000u), __builtin_bit_cast(float, w.w << 16), __builtin_bit_cast(float, w.w & 0xffff0000u)};
                    t += (v[j][0].x * v[j][0].x + v[j][0].y * v[j][0].y) + (v[j][0].z * v[j][0].z + v[j][0].w * v[j][0].w) + (v[j][1].x * v[j][1].x + v[j][1].y * v[j][1].y) + (v[j][1].z * v[j][1].z + v[j][1].w * v[j][1].w); }
                const float rs = 1.0f / sqrtf(wave_sum(t) * (1.0f / D) + 1e-6f);
                float* xo = out + (size_t)(m0 + r) * D + 8 * lane;
#pragma unroll
                for (int j = 0; j < 2; ++j) { *(f32x4*)(xo + 512 * j) = v[j][0] * rs * g4[j][0]; *(f32x4*)(xo + 512 * j + 4) = v[j][1] * rs * g4[j][1]; } }
        }
    }
}

extern "C" void kernel_launch(void* const* d_in, const int* in_sizes, int n_in, void* d_out, int out_size, void* d_ws, size_t ws_size, hipStream_t stream) {
    static int grid = 0;
    if (grid == 0) {
        if (n_in != 22 || ws_size < WS_END) { fprintf(stderr, "kernel_launch: unexpected n_in %d / ws %zu\n", n_in, ws_size); grid = -1; return; }
        int dev = 0, cus = 0, per_cu = 0;
        (void)hipGetDevice(&dev); (void)hipDeviceGetAttribute(&cus, hipDeviceAttributeMultiprocessorCount, dev);
        (void)hipFuncSetAttribute((const void*)fwd_mega, hipFuncAttributeMaxDynamicSharedMemorySize, LDS_BYTES);
        (void)hipOccupancyMaxActiveBlocksPerMultiprocessor(&per_cu, (const void*)fwd_mega, NWAVES * 64, LDS_BYTES);
        if (per_cu < 1) { fprintf(stderr, "kernel_launch: occupancy query says %d blocks per CU\n", per_cu); per_cu = 1; }
        (void)hipGetLastError();
        grid = cus * per_cu;
    }
    if (grid < 0) return;
    Args a{};
    for (int i = 0; i < 22; ++i) a.in[i] = (const float*)d_in[i];
    a.out = (float*)d_out; a.ws = (unsigned char*)d_ws;
    void* args[] = {&a};
    hipError_t e = hipLaunchCooperativeKernel((const void*)fwd_mega, dim3(grid), dim3(NWAVES * 64), args, LDS_BYTES, stream);
    if (e != hipSuccess) fprintf(stderr, "cooperative launch failed: %s (grid %d)\n", hipGetErrorString(e), grid);
}
```

```cpp
#include <hip/hip_runtime.h>
#include <hip/hip_cooperative_groups.h>
#include <hip/hip_bf16.h>
#include <cstdio>
#include <cstdint>
namespace cg = cooperative_groups;
#define SWZ_XOR(v, o) __builtin_bit_cast(float, __builtin_amdgcn_ds_swizzle(__builtin_bit_cast(int, (float)(v)), (((o) << 10) | 0x1F)))
__device__ __forceinline__ float x32_sum(float v) { auto rr = __builtin_amdgcn_permlane32_swap(__builtin_bit_cast(unsigned, v), __builtin_bit_cast(unsigned, v), false, false); return __builtin_bit_cast(float, (unsigned)rr[0]) + __builtin_bit_cast(float, (unsigned)rr[1]); }
__device__ __forceinline__ float x32_max(float v) { auto rr = __builtin_amdgcn_permlane32_swap(__builtin_bit_cast(unsigned, v), __builtin_bit_cast(unsigned, v), false, false); return fmaxf(__builtin_bit_cast(float, (unsigned)rr[0]), __builtin_bit_cast(float, (unsigned)rr[1])); }
__device__ __forceinline__ float x32_other(float v, int hi) { auto rr = __builtin_amdgcn_permlane32_swap(__builtin_bit_cast(unsigned, v), __builtin_bit_cast(unsigned, v), false, false); return hi ? __builtin_bit_cast(float, (unsigned)rr[0]) : __builtin_bit_cast(float, (unsigned)rr[1]); }
__device__ __forceinline__ float wave_sum(float v) { v += SWZ_XOR(v, 1); v += SWZ_XOR(v, 2); v += SWZ_XOR(v, 4); v += SWZ_XOR(v, 8); v += SWZ_XOR(v, 16); return x32_sum(v); }
namespace pg8 {
#define PG8_LAS __attribute__((address_space(3)))
typedef unsigned short bf16_t;
typedef short bf16x8 __attribute__((ext_vector_type(8)));
typedef float f32x4 __attribute__((ext_vector_type(4)));
typedef unsigned u32x4 __attribute__((ext_vector_type(4)));
constexpr int BM = 256, BK = 64, HALF = 128, HTB = HALF * BK * 2  , STAGE_BYTES = 8 * HTB, NXCD = 8, WGM = 8;

__host__ __device__ __forceinline__ int lds_byte(int r, int c) { const int st = (r >> 4) * 2 + (c >> 5), rr = r & 15, cc = c & 31, ob = rr * 64 + cc * 2; return st * 1024 + (ob ^ (((ob >> 9) & 1) << 5)); }
__host__ __device__ __forceinline__ void stage_rc(int b, int& R, int& C) { const int st = b / 1024, sb = b % 1024, swz = sb ^ (((sb >> 9) & 1) << 5); R = (st >> 1) * 16 + swz / 64; C = (st & 1) * 32 + (swz % 64) / 2; }
__host__ __device__ __forceinline__ int perm32(int rho) { const int n = rho >> 4, i = rho & 15; return 8 * (i >> 2) + 4 * n + (i & 3); }

struct Unit { int pm, pn, ord; };
struct Gemm { const bf16_t* A; const bf16_t* Bt; int M, N, K, lda, ldb; };

struct StaticOrder {
    int nM, nN, nwg, G, c;
    __host__ __device__ void init(int M, int N, int G_, int c_) { nM = M / BM; nN = N / BM; nwg = nM * nN; G = G_; c = c_; }
    __host__ __device__ bool next(int i, Unit& u) const {
        const long L = (long)i * G + c; if (L >= nwg) return false;
        int wgid = (int)L; { const int q = nwg / NXCD, r = nwg % NXCD, xcd = wgid % NXCD, off = wgid / NXCD; wgid = (xcd < r ? xcd * (q + 1) : r * (q + 1) + (xcd - r) * q) + off; }
        const int nig = WGM * nN, gid = wgid / nig, fm = gid * WGM, gsz = (nM - fm) < WGM ? (nM - fm) : WGM;
        u.pm = fm + ((wgid % nig) % gsz); u.pn = (wgid % nig) / gsz; u.ord = i; return true;
    }
    __device__ __forceinline__ void a_ready(const Unit&) const {}
    __device__ __forceinline__ void done(const Unit&) const {}
};

typedef float f32x2 __attribute__((ext_vector_type(2)));
typedef __bf16 bf16x2_t __attribute__((ext_vector_type(2)));
typedef unsigned u32x2 __attribute__((ext_vector_type(2)));
__device__ __forceinline__ unsigned cvt_pk_bf16(float lo, float hi) { f32x2 v = {lo, hi}; bf16x2_t b = __builtin_convertvector(v, bf16x2_t); return __builtin_bit_cast(unsigned, b); }
constexpr float RMS_EPS = 1e-6f;
constexpr float LOG2E = 1.4426950408889634f;
__device__ __forceinline__ float sum16(const float* p) { const f32x4 a = *(const f32x4*)p, b = *(const f32x4*)(p + 4), c = *(const f32x4*)(p + 8), d = *(const f32x4*)(p + 12);
    return ((a[0] + a[1]) + (a[2] + a[3])) + ((b[0] + b[1]) + (b[2] + b[3])) + ((c[0] + c[1]) + (c[2] + c[3])) + ((d[0] + d[1]) + (d[2] + d[3])); }
__device__ __forceinline__ float sum4(const float* p) { const f32x4 a = *(const f32x4*)p; return (a[0] + a[1]) + (a[2] + a[3]); }
__device__ __forceinline__ float dot4(const f32x4 a) { return (a[0] * a[0] + a[1] * a[1]) + (a[2] * a[2] + a[3] * a[3]); }
__device__ __forceinline__ void rope4(f32x4& x1, f32x4& x2, const f32x4 c, const f32x4 s) { const f32x4 a = x1 * c - x2 * s, b = x2 * c + x1 * s; x1 = a; x2 = b; }

struct EpiUp {
    static constexpr bool PERM = true, AFTER_DRAIN = false;
    bf16_t* H; const PG8_LAS float* rst; int ldh;
    __device__ __forceinline__ void operator()(const f32x4 (&acc)[2][2][4][2], const Unit& u, int wr, int wc, int fr, int fq) const {
        const int rl0 = wr * 64 + fr, row0 = u.pm * BM + rl0, col0 = u.pn * HALF + wc * 32 + 8 * fq;
        const PG8_LAS float* rt = rst + u.ord * BM + rl0;
#pragma unroll
        for (int ai = 0; ai < 2; ++ai)
#pragma unroll
            for (int m = 0; m < 4; ++m) { const int row = row0 + ai * HALF + m * 16;
                const float rs = rt[ai * HALF + m * 16], rs2 = rs * rs, c1 = -rs * LOG2E;
                float hv[8];
#pragma unroll
                for (int n = 0; n < 2; ++n)
#pragma unroll
                    for (int e = 0; e < 4; ++e) { const float ag = acc[ai][0][m][n][e], au = acc[ai][1][m][n][e];
                        hv[n * 4 + e] = (ag * au) * (rs2 * __builtin_amdgcn_rcpf(1.0f + __builtin_amdgcn_exp2f(ag * c1))); }
                u32x4 w; w.x = cvt_pk_bf16(hv[0], hv[1]); w.y = cvt_pk_bf16(hv[2], hv[3]); w.z = cvt_pk_bf16(hv[4], hv[5]); w.w = cvt_pk_bf16(hv[6], hv[7]);
                *(u32x4*)(H + (size_t)row * ldh + col0) = w; }
    }
};
__device__ __forceinline__ float bf_lo(unsigned w) { return __builtin_bit_cast(float, w << 16); }
__device__ __forceinline__ float bf_hi(unsigned w) { return __builtin_bit_cast(float, w & 0xffff0000u); }
struct EpiRes {
    static constexpr bool PERM = true, AFTER_DRAIN = false;
    bf16_t* xb; float* part; float s;
    __device__ __forceinline__ void operator()(const f32x4 (&acc)[2][2][4][2], const Unit& u, int wr, int wc, int fr, int fq) const {
        const int row0 = u.pm * BM + wr * 64 + fr, col0 = u.pn * BM + wc * 32 + 8 * fq;
#pragma unroll
        for (int ai = 0; ai < 2; ++ai) {
            u32x4 pre[4][2];
#pragma unroll
            for (int m = 0; m < 4; ++m) { const size_t off = (size_t)(row0 + ai * HALF + m * 16) * 1024 + col0;
#pragma unroll
                for (int bj = 0; bj < 2; ++bj) pre[m][bj] = *(const u32x4*)(xb + off + bj * HALF); }
#pragma unroll
            for (int m = 0; m < 4; ++m) { const int row = row0 + ai * HALF + m * 16; const size_t off = (size_t)row * 1024 + col0; float ss = 0.f;
#pragma unroll
                for (int bj = 0; bj < 2; ++bj) { const u32x4 b = pre[m][bj];
                    const f32x4 v0 = (f32x4){bf_lo(b.x), bf_hi(b.x), bf_lo(b.y), bf_hi(b.y)} + acc[ai][bj][m][0] * s;
                    const f32x4 v1 = (f32x4){bf_lo(b.z), bf_hi(b.z), bf_lo(b.w), bf_hi(b.w)} + acc[ai][bj][m][1] * s;
                    u32x4 w; w.x = cvt_pk_bf16(v0[0], v0[1]); w.y = cvt_pk_bf16(v0[2], v0[3]); w.z = cvt_pk_bf16(v1[0], v1[1]); w.w = cvt_pk_bf16(v1[2], v1[3]);
                    *(u32x4*)(xb + off + bj * HALF) = w; ss += dot4(v0) + dot4(v1); }
                ss += SWZ_XOR(ss, 16); ss = x32_sum(ss);
                if (fq == 0) part[(size_t)row * 16 + u.pn * 4 + wc] = ss; }
            asm volatile("" ::: "memory"); }
    }
};
struct EpiIn {
    static constexpr bool PERM = true, AFTER_DRAIN = false;
    bf16_t* P; const PG8_LAS float* rst; float* partq; float* partkv; const float* cosd; const float* sind; const float* cosm; const float* sinm; int ldp; float qscale;
    __device__ __forceinline__ void operator()(const f32x4 (&acc)[2][2][4][2], const Unit& u, int wr, int wc, int fr, int fq) const {
        const int tile = u.pn; const int rl0 = wr * 64 + fr, row0 = u.pm * BM + rl0, col0 = tile * BM + wc * 32 + 8 * fq;
        const PG8_LAS float* rt = rst + u.ord * BM + rl0;
        const float cs = (tile < 2 || tile == 8) ? qscale : 1.0f;
        const bool ropeD = (tile < 4) && ((wc & 1) == 0) && (fq < 2);
        const bool ropeM = (tile == 7) && (wc == 0);
        const float* ct = ropeD ? cosd : cosm; const float* sn = ropeD ? sind : sinm; const int sh = ropeD ? 3 : 4;
#pragma unroll
        for (int ai = 0; ai < 2; ++ai) {
            f32x4 rc[4], rsn[4];
            if (ropeD || ropeM) {
#pragma unroll
                for (int m = 0; m < 4; ++m) { const int pos = (row0 + ai * HALF + m * 16) & 4095; rc[m] = *(const f32x4*)(ct + (pos << sh) + 4 * fq); rsn[m] = *(const f32x4*)(sn + (pos << sh) + 4 * fq); } }
#pragma unroll
            for (int m = 0; m < 4; ++m) { const int row = row0 + ai * HALF + m * 16;
                const float rs = cs * rt[ai * HALF + m * 16];
                f32x4 v[2][2];
#pragma unroll
                for (int bj = 0; bj < 2; ++bj)
#pragma unroll
                    for (int n = 0; n < 2; ++n) v[bj][n] = acc[ai][bj][m][n] * rs;
                if (ropeD) { rope4(v[0][0], v[0][1], rc[m], rsn[m]); rope4(v[1][0], v[1][1], rc[m], rsn[m]); }
                if (ropeM) { rope4(v[1][0], v[1][1], rc[m], rsn[m]); }
                if (tile == 6) { float ss = (dot4(v[0][0]) + dot4(v[0][1])) + (dot4(v[1][0]) + dot4(v[1][1])); ss += SWZ_XOR(ss, 16); ss = x32_sum(ss); if (fq == 0) partq[(size_t)row * 4 + wc] = ss; }
                if (tile == 7) { float ss = dot4(v[0][0]) + dot4(v[0][1]); ss += SWZ_XOR(ss, 16); ss = x32_sum(ss); if (fq == 0) partkv[(size_t)row * 4 + wc] = ss; }
#pragma unroll
                for (int bj = 0; bj < 2; ++bj) { u32x4 w; w.x = cvt_pk_bf16(v[bj][0][0], v[bj][0][1]); w.y = cvt_pk_bf16(v[bj][0][2], v[bj][0][3]); w.z = cvt_pk_bf16(v[bj][1][0], v[bj][1][1]); w.w = cvt_pk_bf16(v[bj][1][2], v[bj][1][3]);
                    *(u32x4*)(P + (size_t)row * ldp + col0 + bj * HALF) = w; }
                asm volatile("" ::: "memory"); } }
    }
};
template <bool ROPE> struct EpiMla {
    static constexpr bool PERM = true, AFTER_DRAIN = false;
    bf16_t* O; const PG8_LAS float* rst; const float* cosm; const float* sinm; int ldo;
    __device__ __forceinline__ void operator()(const f32x4 (&acc)[2][2][4][2], const Unit& u, int wr, int wc, int fr, int fq) const {
        const int rl0 = wr * 64 + fr, row0 = u.pm * BM + rl0, col0 = u.pn * BM + wc * 32 + 8 * fq;
        const PG8_LAS float* rt = rst + u.ord * BM + rl0;
#pragma unroll
        for (int ai = 0; ai < 2; ++ai)
#pragma unroll
            for (int m = 0; m < 4; ++m) { const int row = row0 + ai * HALF + m * 16; const int pos = row & 4095;
                const float rs = rt[ai * HALF + m * 16];
                f32x4 v[2][2];
#pragma unroll
                for (int bj = 0; bj < 2; ++bj)
#pragma unroll
                    for (int n = 0; n < 2; ++n) v[bj][n] = acc[ai][bj][m][n] * rs;
                if (ROPE && wc == 2) { const f32x4 c = *(const f32x4*)(cosm + pos * 16 + 4 * fq), s = *(const f32x4*)(sinm + pos * 16 + 4 * fq); rope4(v[0][0], v[0][1], c, s); rope4(v[1][0], v[1][1], c, s); }
#pragma unroll
                for (int bj = 0; bj < 2; ++bj) { u32x4 w; w.x = cvt_pk_bf16(v[bj][0][0], v[bj][0][1]); w.y = cvt_pk_bf16(v[bj][0][2], v[bj][0][3]); w.z = cvt_pk_bf16(v[bj][1][0], v[bj][1][1]); w.w = cvt_pk_bf16(v[bj][1][2], v[bj][1][3]);
                    *(u32x4*)(O + (size_t)row * ldo + col0 + bj * HALF) = w; }
                asm volatile("" ::: "memory"); }
    }
};

template <int NP, class Sched>
__device__ __forceinline__ void fill_rowscale(PG8_LAS float* tab, const Sched& S, const float* parts, float inv_n, float scale, int tid) {
    Unit u; int nu = 0; while (S.next(nu, u)) ++nu;
    constexpr bool WIDE = (NP == 16);
    const int r0 = WIDE ? (tid >> 2) : (tid & 255), q = WIDE ? (tid & 3) : 0;
    const bool on = WIDE || tid < 256;
    f32x4 c0 = {0.f, 0.f, 0.f, 0.f}, c1 = c0, n0 = c0, n1 = c0;
    if (nu > 0 && on) { S.next(0, u); const float* p = parts + ((size_t)u.pm * BM + r0) * NP + q * 4; c0 = *(const f32x4*)p; if (WIDE) c1 = *(const f32x4*)(p + 128 * NP); }
    for (int i = 0; i < nu; ++i) {
        if (i + 1 < nu && on) { S.next(i + 1, u); const float* p = parts + ((size_t)u.pm * BM + r0) * NP + q * 4; n0 = *(const f32x4*)p; if (WIDE) n1 = *(const f32x4*)(p + 128 * NP); }
        float s0 = (c0[0] + c0[1]) + (c0[2] + c0[3]), s1 = (c1[0] + c1[1]) + (c1[2] + c1[3]);
        if (WIDE) { s0 += SWZ_XOR(s0, 1); s0 += SWZ_XOR(s0, 2); s1 += SWZ_XOR(s1, 1); s1 += SWZ_XOR(s1, 2); }
        if (on && q == 0) { tab[i * BM + r0] = scale / sqrtf(s0 * inv_n + RMS_EPS); if (WIDE) tab[i * BM + 128 + r0] = scale / sqrtf(s1 * inv_n + RMS_EPS); }
        c0 = n0; c1 = n1;
    }
    asm volatile("s_waitcnt lgkmcnt(0)" ::: "memory"); __builtin_amdgcn_s_barrier(); asm volatile("" ::: "memory");
}
template <class Epi, class Sched, bool ALIGN_EPI = false, bool SP2 = false>
__device__ __forceinline__ void gemm_phase(PG8_LAS unsigned char* lds, const Gemm g, const Sched& S, const Epi& E, int wave_in  ) {
    unsigned m_ = ~0u; asm volatile("" : "+s"(m_), "+s"(wave_in)); const int tid_ = wave_in * 64 + (int)__builtin_amdgcn_mbcnt_hi(m_, __builtin_amdgcn_mbcnt_lo(m_, 0u));
    const int tid = tid_, wid = __builtin_amdgcn_readfirstlane(tid >> 6), lane = tid & 63, wr = wid >> 2, wc = wid & 3, fr = lane & 15, fq = lane >> 4;
    const int K = g.K, nt = K / BK;
    unsigned voffA[2], voffB[2];
#pragma unroll
    for (int i = 0; i < 2; ++i) { int R, C; stage_rc(tid * 16 + i * 8192, R, C); const int Rb = Epi::PERM ? ((R & ~31) + perm32(R & 31)) : R;
        voffA[i] = (unsigned)(R * g.lda + C) * 2u; voffB[i] = (unsigned)(Rb * g.ldb + C) * 2u; }
    const size_t kstep = (size_t)(BK * 2);
    const size_t hstepA = (size_t)HALF * g.lda * 2, hstepB = (size_t)HALF * g.ldb * 2;
    const size_t tstepA = 2 * hstepA, tstepB = 2 * hstepB;
    const unsigned ldsw = (unsigned)wid * 1024u;
    const int aoff = lds_byte(wr * 64 + fr, fq * 8), boff = lds_byte(wc * 32 + fr, fq * 8);
#define PG8_SA(b, h) (((b) * 2 + (h)) * HTB)
#define PG8_SB(b, h) ((4 + (b) * 2 + (h)) * HTB)
#define PG8_STAGE(bufoff, gbase, voff) do { _Pragma("unroll") for (int _i = 0; _i < 2; ++_i) \
        __builtin_amdgcn_global_load_lds((const unsigned*)((const char*)(gbase) + (voff)[_i]), (PG8_LAS unsigned*)(lds + (bufoff) + ldsw + _i * 8192), 16, 0, 0); } while (0)
#define PG8_LDA(dst, b, h) do { _Pragma("unroll") for (int m = 0; m < 4; ++m) _Pragma("unroll") for (int k = 0; k < 2; ++k) dst[m][k] = *(const PG8_LAS bf16x8*)(lds + PG8_SA(b, h) + aoff + m * 2048 + k * 1024); } while (0)
#define PG8_LDB(dst, b, h) do { _Pragma("unroll") for (int n = 0; n < 2; ++n) _Pragma("unroll") for (int k = 0; k < 2; ++k) dst[n][k] = *(const PG8_LAS bf16x8*)(lds + PG8_SB(b, h) + boff + n * 2048 + k * 1024); } while (0)
#define PG8_MMA(ai, bj, At, Bt) do { __builtin_amdgcn_s_setprio(1); _Pragma("unroll") for (int m = 0; m < 4; ++m) _Pragma("unroll") for (int n = 0; n < 2; ++n) _Pragma("unroll") for (int k = 0; k < 2; ++k) \
        acc[ai][bj][m][n] = __builtin_amdgcn_mfma_f32_16x16x32_bf16(Bt[n][k], At[m][k], acc[ai][bj][m][n], 0, 0, 0); __builtin_amdgcn_s_setprio(0); } while (0)
#define PG8_WAIT_V(n) asm volatile("s_waitcnt vmcnt(" #n ")" ::: "memory")
#define PG8_WAIT_L(n) asm volatile("s_waitcnt lgkmcnt(" #n ")" ::: "memory")
#define PG8_BAR __builtin_amdgcn_s_barrier()
#define PG8_SCHED __builtin_amdgcn_sched_barrier(0)
    Unit cur, nxt; int ui = 0;
    if (!S.next(0, cur)) return;
    f32x4 acc[2][2][4][2];
#pragma unroll
    for (int a = 0; a < 2; ++a)
#pragma unroll
        for (int b = 0; b < 2; ++b)
#pragma unroll
            for (int m = 0; m < 4; ++m)
#pragma unroll
                for (int n = 0; n < 2; ++n) acc[a][b][m][n] = (f32x4){0.f, 0.f, 0.f, 0.f};
    bf16x8 At[4][2], B0[2][2], B1[2][2];
    const char* cA = (const char*)g.A + (size_t)cur.pm * tstepA; const char* cB = (const char*)g.Bt + (size_t)cur.pn * tstepB;
    S.a_ready(cur);
    if constexpr (SP2) {
        PG8_STAGE(PG8_SB(0, 0), cB, voffB); PG8_STAGE(PG8_SB(0, 1), cB + hstepB, voffB); PG8_STAGE(PG8_SA(0, 0), cA, voffA); PG8_STAGE(PG8_SA(0, 1), cA + hstepA, voffA);
        if (wr == 1) PG8_BAR;
        PG8_WAIT_V(2); PG8_BAR;
        PG8_STAGE(PG8_SB(1, 0), cB + kstep, voffB); PG8_STAGE(PG8_SA(1, 0), cA + kstep, voffA); PG8_STAGE(PG8_SB(1, 1), cB + hstepB + kstep, voffB);
        PG8_WAIT_V(6); PG8_BAR;
    } else {
        PG8_STAGE(PG8_SB(0, 0), cB, voffB); PG8_STAGE(PG8_SA(0, 0), cA, voffA); PG8_STAGE(PG8_SB(0, 1), cB + hstepB, voffB); PG8_STAGE(PG8_SA(0, 1), cA + hstepA, voffA);
        if (wr == 1) PG8_BAR;
        PG8_WAIT_V(4); PG8_BAR;
        PG8_STAGE(PG8_SB(1, 0), cB + kstep, voffB); PG8_STAGE(PG8_SA(1, 0), cA + kstep, voffA); PG8_STAGE(PG8_SB(1, 1), cB + hstepB + kstep, voffB);
        PG8_WAIT_V(6); PG8_BAR;
    }
    for (;;) {
        const bool has_next = S.next(ui + 1, nxt);
        const char* nA = has_next ? (const char*)g.A + (size_t)nxt.pm * tstepA : cA; const char* nB = has_next ? (const char*)g.Bt + (size_t)nxt.pn * tstepB : cB;
        for (int t = 0; t < nt; t += 2) {
            const bool last = (t == nt - 2);
            const char* a1 = cA + (size_t)(t + 1) * kstep;
            const char* a2 = last ? nA : cA + (size_t)(t + 2) * kstep; const char* b2 = last ? nB : cB + (size_t)(t + 2) * kstep;
            const char* a3 = a2 + kstep; const char* b3 = b2 + kstep;
            if (last && has_next) S.a_ready(nxt);
            if constexpr (SP2) {
            PG8_LDB(B0, 0, 0); PG8_LDB(B1, 0, 1); PG8_SCHED; PG8_LDA(At, 0, 0); PG8_STAGE(PG8_SA(1, 1), a1 + hstepA, voffA);
            PG8_WAIT_V(8); PG8_WAIT_L(0); PG8_BAR; PG8_MMA(0, 0, At, B0); PG8_MMA(0, 1, At, B1); PG8_BAR; PG8_SCHED;
            PG8_LDA(At, 0, 1); PG8_STAGE(PG8_SB(0, 0), b2, voffB); PG8_STAGE(PG8_SB(0, 1), b2 + hstepB, voffB); PG8_STAGE(PG8_SA(0, 0), a2, voffA);
            PG8_WAIT_V(8); PG8_WAIT_L(0); PG8_BAR; PG8_MMA(1, 0, At, B0); PG8_MMA(1, 1, At, B1); PG8_BAR; PG8_SCHED;
            PG8_LDB(B0, 1, 0); PG8_LDB(B1, 1, 1); PG8_SCHED; PG8_LDA(At, 1, 0); PG8_STAGE(PG8_SA(0, 1), a2 + hstepA, voffA);
            PG8_WAIT_V(8); PG8_WAIT_L(0); PG8_BAR; PG8_MMA(0, 0, At, B0); PG8_MMA(0, 1, At, B1); PG8_BAR; PG8_SCHED;
            PG8_LDA(At, 1, 1); PG8_STAGE(PG8_SB(1, 0), b3, voffB); PG8_STAGE(PG8_SB(1, 1), b3 + hstepB, voffB); PG8_STAGE(PG8_SA(1, 0), a3, voffA);
            PG8_WAIT_V(8); PG8_WAIT_L(0); PG8_BAR; PG8_MMA(1, 0, At, B0); PG8_MMA(1, 1, At, B1); PG8_BAR; PG8_SCHED;
            } else {
            PG8_LDB(B0, 0, 0); PG8_SCHED; PG8_LDA(At, 0, 0); PG8_STAGE(PG8_SA(1, 1), a1 + hstepA, voffA);
            PG8_WAIT_L(8); PG8_BAR; PG8_WAIT_L(0); PG8_MMA(0, 0, At, B0); PG8_BAR; PG8_SCHED;
            PG8_LDB(B1, 0, 1); PG8_STAGE(PG8_SB(0, 0), b2, voffB);
            PG8_BAR; PG8_WAIT_L(0); PG8_MMA(0, 1, At, B1); PG8_BAR;
            PG8_LDA(At, 0, 1); PG8_STAGE(PG8_SA(0, 0), a2, voffA);
            PG8_BAR; PG8_WAIT_L(0); PG8_MMA(1, 0, At, B0); PG8_BAR; PG8_SCHED;
            PG8_STAGE(PG8_SB(0, 1), b2 + hstepB, voffB);
            PG8_WAIT_V(6); PG8_BAR; PG8_MMA(1, 1, At, B1); PG8_BAR;
            PG8_LDB(B0, 1, 0); PG8_SCHED; PG8_LDA(At, 1, 0); PG8_STAGE(PG8_SA(0, 1), a2 + hstepA, voffA);
            PG8_WAIT_L(8); PG8_BAR; PG8_WAIT_L(0); PG8_MMA(0, 0, At, B0); PG8_BAR; PG8_SCHED;
            PG8_LDB(B1, 1, 1); PG8_STAGE(PG8_SB(1, 0), b3, voffB);
            PG8_BAR; PG8_WAIT_L(0); PG8_MMA(0, 1, At, B1); PG8_BAR;
            PG8_LDA(At, 1, 1); PG8_STAGE(PG8_SA(1, 0), a3, voffA);
            PG8_BAR; PG8_WAIT_L(0); PG8_MMA(1, 0, At, B0); PG8_BAR; PG8_SCHED;
            PG8_STAGE(PG8_SB(1, 1), b3 + hstepB, voffB);
            PG8_WAIT_V(6); PG8_BAR; PG8_MMA(1, 1, At, B1); PG8_BAR;
            }
        }
        if constexpr (ALIGN_EPI) { if (wr == 0) PG8_BAR; }
        if constexpr (!Epi::AFTER_DRAIN) { unsigned m2_ = ~0u; asm volatile("" : "+s"(m2_)); const int ln_ = (int)__builtin_amdgcn_mbcnt_hi(m2_, __builtin_amdgcn_mbcnt_lo(m2_, 0u)); E(acc, cur, wr, wc, ln_ & 15, ln_ >> 4); S.done(cur); }
        if (!has_next) break;
#pragma unroll
        for (int a = 0; a < 2; ++a)
#pragma unroll
            for (int b = 0; b < 2; ++b)
#pragma unroll
                for (int m = 0; m < 4; ++m)
#pragma unroll
                    for (int n = 0; n < 2; ++n) acc[a][b][m][n] = (f32x4){0.f, 0.f, 0.f, 0.f};
        cur = nxt; cA = nA; cB = nB; ++ui;
        if constexpr (ALIGN_EPI) { if (wr == 1) PG8_BAR; }
    }
    PG8_WAIT_V(0);
    if constexpr (!ALIGN_EPI) { if (wr == 0) PG8_BAR; }
    PG8_BAR;
    if constexpr (Epi::AFTER_DRAIN) { E.fused(acc, cur, wr, wc, fr, fq, lds, wid, lane); S.done(cur); }
#undef PG8_SA
#undef PG8_SB
#undef PG8_STAGE
#undef PG8_LDA
#undef PG8_LDB
#undef PG8_MMA
#undef PG8_WAIT_V
#undef PG8_WAIT_L
#undef PG8_BAR
#undef PG8_SCHED
}
}
namespace att {
#define LAS3 __attribute__((address_space(3)))
typedef unsigned short bf16_t;
typedef short bf16x8 __attribute__((ext_vector_type(8)));
typedef short s16x4 __attribute__((ext_vector_type(4)));
typedef float f32x16 __attribute__((ext_vector_type(16)));
typedef float f32x4 __attribute__((ext_vector_type(4)));
typedef float f32x2_t __attribute__((ext_vector_type(2)));
typedef __bf16 bf16x2_t __attribute__((ext_vector_type(2)));
typedef unsigned u32x4 __attribute__((ext_vector_type(4)));
typedef unsigned u32x2 __attribute__((ext_vector_type(2)));
typedef short v4i16_t __attribute__((ext_vector_type(4)));
constexpr int SEQ = 4096;
constexpr int LDS_SBV = 0;
__device__ __forceinline__ unsigned cvtpk(float lo, float hi) { f32x2_t v = {lo, hi}; bf16x2_t b = __builtin_convertvector(v, bf16x2_t); return __builtin_bit_cast(unsigned, b); }
__device__ __forceinline__ s16x4 vtr(const LAS3 char* p) { return __builtin_bit_cast(s16x4, __builtin_amdgcn_ds_read_tr16_b64_v4i16((LAS3 v4i16_t*)p)); }
__device__ __forceinline__ void glds16(const void* gsrc, unsigned lds_dst) { unsigned keep;
    asm volatile("s_mov_b32 %0, m0\n\ts_mov_b32 m0, %2\n\ts_nop 0\n\tglobal_load_lds_dwordx4 %1, off\n\ts_mov_b32 m0, %0" : "=&s"(keep) : "v"(gsrc), "s"(lds_dst) : "memory"); }
__device__ __forceinline__ float ex2(float x) { return __builtin_amdgcn_exp2f(x); }
__device__ __forceinline__ float lg2(float x) { return __builtin_amdgcn_logf(x); }
#define ATT_MFMA(a, b, c) __builtin_amdgcn_mfma_f32_32x32x16_bf16((a), (b), (c), 0, 0, 0)
#define ATT_VFR(lo, hi) (bf16x8){lo[0], lo[1], lo[2], lo[3], hi[0], hi[1], hi[2], hi[3]}

template <int NQK>
__device__ __forceinline__ void sm_qk(f32x16& p0, f32x16& p1, const bf16x8 (&qf)[NQK], const LAS3 char* ks, const int (&ko)[NQK]) {
    constexpr int H = NQK / 2;
    bf16x8 kf[2][H][2];
#pragma unroll
    for (int j = 0; j < H; ++j) { kf[0][j][0] = *(const LAS3 bf16x8*)(ks + ko[j]); kf[0][j][1] = *(const LAS3 bf16x8*)(ks + ko[j] + (j < 4 ? 4096 : 2048)); }
    __builtin_amdgcn_sched_barrier(0);
#pragma unroll
    for (int j = 0; j < H; ++j) { kf[1][j][0] = *(const LAS3 bf16x8*)(ks + ko[H + j]); kf[1][j][1] = *(const LAS3 bf16x8*)(ks + ko[H + j] + ((H + j) < 4 ? 4096 : 2048)); }
    p0 = f32x16{}; p1 = f32x16{};
#pragma unroll
    for (int j = 0; j < H; ++j) { p0 = ATT_MFMA(kf[0][j][0], qf[j], p0); p1 = ATT_MFMA(kf[0][j][1], qf[j], p1); }
    __builtin_amdgcn_sched_barrier(0);
#pragma unroll
    for (int j = 0; j < H; ++j) { p0 = ATT_MFMA(kf[1][j][0], qf[H + j], p0); p1 = ATT_MFMA(kf[1][j][1], qf[H + j], p1); }
    __builtin_amdgcn_sched_barrier(0);
}
template <int NV>
__device__ __forceinline__ void sm_softmax_pv(f32x16 (&o)[NV], float& m_ref, float& l_run, f32x16& p0, f32x16& p1, const LAS3 char* vb) {
    s16x4 vl[2][NV], vh[2][NV];
#pragma unroll
    for (int d0 = 0; d0 < NV; ++d0) { vl[0][d0] = vtr(vb + d0 * 4096); vh[0][d0] = vtr(vb + d0 * 4096 + 512); }
    float mx = fmaxf(p0[0], p1[0]);
#pragma unroll
    for (int r = 1; r < 16; ++r) mx = fmaxf(fmaxf(mx, p0[r]), p1[r]);
    mx = x32_max(mx);
    if (__any(mx > m_ref + 8.0f)) {
        const float mn = fmaxf(m_ref, mx), alpha = ex2(m_ref - mn); m_ref = mn; l_run *= alpha;
#pragma unroll
        for (int d0 = 0; d0 < NV; ++d0)
#pragma unroll
            for (int r = 0; r < 16; ++r) o[d0][r] *= alpha;
    }
    float s = 0.f;
#pragma unroll
    for (int r = 0; r < 16; ++r) { p0[r] = ex2(p0[r] - m_ref); p1[r] = ex2(p1[r] - m_ref); s += p0[r] + p1[r]; }
    l_run += s;
    u32x4 pw[4];
#pragma unroll
    for (int i = 0; i < 4; ++i) { pw[0][i] = cvtpk(p0[2 * i], p0[2 * i + 1]); pw[1][i] = cvtpk(p0[8 + 2 * i], p0[9 + 2 * i]); pw[2][i] = cvtpk(p1[2 * i], p1[2 * i + 1]); pw[3][i] = cvtpk(p1[8 + 2 * i], p1[9 + 2 * i]); }
    __builtin_amdgcn_sched_barrier(0);
#pragma unroll
    for (int ks = 0; ks < 4; ++ks) {
        if (ks < 3) {
#pragma unroll
            for (int d0 = 0; d0 < NV; ++d0) { vl[(ks + 1) & 1][d0] = vtr(vb + d0 * 4096 + (ks + 1) * 1024); vh[(ks + 1) & 1][d0] = vtr(vb + d0 * 4096 + (ks + 1) * 1024 + 512); } }
#pragma unroll
        for (int d0 = 0; d0 < NV; ++d0) o[d0] = ATT_MFMA(ATT_VFR(vl[ks & 1][d0], vh[ks & 1][d0]), __builtin_bit_cast(bf16x8, pw[ks]), o[d0]);
        __builtin_amdgcn_sched_barrier(0); }
}

template <int NQK, int NV>
__device__ __forceinline__ void sm_pass(f32x16 (&o)[NV], const bf16x8 (&qf)[NQK], int nt_wg, int nt_wave, const bf16_t* k0p, int k0pitch, const bf16_t* k1p, int k1pitch,
                                        const bf16_t* vp, int vpitch, LAS3 char* lds, int wave, int lane) {
    static_assert((NQK == 4 && NV == 4) || (NQK == 6 && NV == 2), "3 DMA instructions per wave per tile");
    constexpr int NKW = (NQK == 4) ? 1 : 2, NVW = NV / 2;
    constexpr int KSLOT = 12288, VSLOT = 16384, VBASE = 3 * KSLOT;
    const int r32 = lane & 31, hi = lane >> 5;
    const LAS3 char* kp = lds;
    const unsigned lds0 = (unsigned)(unsigned long)lds;
    int ko[NQK];
#pragma unroll
    for (int j = 0; j < NQK; ++j) ko[j] = (j < 4) ? r32 * 128 + (((2 * j + hi) ^ ((r32 >> 1) & 7)) * 16) : 8192 + r32 * 64 + (((2 * (j - 4) + hi) ^ ((r32 >> 2) & 3)) * 16);
    const LAS3 char* vb = lds + VBASE + ((lane >> 4) & 1) * 32 + (lane & 3) * 8 + (4 * hi + ((lane & 15) >> 2)) * 64;
    float m_ref = -1e30f, l_run = 0.f;
#pragma unroll
    for (int d0 = 0; d0 < NV; ++d0) o[d0] = f32x16{};
    const int krow0 = 8 * wave + (lane >> 3), krow1 = 16 * (wave & 3) + (lane >> 2);
    const int koff0 = (krow0 * k0pitch + (((lane & 7) ^ ((krow0 >> 1) & 7)) * 8)) * 2, koff1 = (krow1 * k1pitch + (((lane & 3) ^ ((krow1 >> 2) & 3)) * 8)) * 2;
    const int voffl = ((lane >> 2) * vpitch + (lane & 3) * 8) * 2;
#define ATT_DMA_K(t, slot) do { \
        glds16((const char*)k0p + (size_t)(t) * 64 * k0pitch * 2 + koff0, (unsigned)__builtin_amdgcn_readfirstlane((int)(lds0 + (slot) * KSLOT + wave * 1024))); \
        if (NQK == 6) glds16((const char*)k1p + (size_t)(t) * 64 * k1pitch * 2 + koff1, (unsigned)__builtin_amdgcn_readfirstlane((int)(lds0 + (slot) * KSLOT + 8192 + (wave & 3) * 1024))); } while (0)
#define ATT_DMA_V(t, slot) do { _Pragma("unroll") for (int i = 0; i < NVW; ++i) { const int ch = wave + 8 * i; \
        const char* src = (const char*)vp + ((size_t)((t) * 64 + (ch & 3) * 16) * vpitch + (ch >> 2) * 32) * 2 + voffl; \
        glds16(src, (unsigned)__builtin_amdgcn_readfirstlane((int)(lds0 + VBASE + (slot) * VSLOT + ch * 1024))); } } while (0)
#define ATT_WAITBAR(N) asm volatile("s_waitcnt vmcnt(" #N ") lgkmcnt(0)\n\ts_barrier" ::: "memory")
    f32x16 a0, a1, b0, b1;
    ATT_WAITBAR(0);
    ATT_DMA_K(0, 0); ATT_DMA_V(0, 0); ATT_DMA_K(1, 1); ATT_DMA_V(1, 1); ATT_DMA_K(2, 2);
    ATT_WAITBAR(3);
    sm_qk<NQK>(a0, a1, qf, kp, ko);
    int s0 = 0, s1 = 1, s2 = 2;
#define ATT_STEP(tt, C0, C1, N0, N1, QKFIRST) do { \
        if ((tt) + 2 < nt_wg) ATT_WAITBAR(3); else ATT_WAITBAR(0); \
        if ((tt) + 3 < nt_wg) ATT_DMA_K((tt) + 3, s0); \
        if ((tt) + 2 < nt_wg) ATT_DMA_V((tt) + 2, s2); \
        if (QKFIRST) { sm_qk<NQK>(N0, N1, qf, kp + s1 * KSLOT, ko); if ((tt) < nt_wave) sm_softmax_pv<NV>(o, m_ref, l_run, C0, C1, vb + s0 * VSLOT); } \
        else { if ((tt) < nt_wave) sm_softmax_pv<NV>(o, m_ref, l_run, C0, C1, vb + s0 * VSLOT); sm_qk<NQK>(N0, N1, qf, kp + s1 * KSLOT, ko); } \
        { const int s_ = s0; s0 = s1; s1 = s2; s2 = s_; } } while (0)
    if (wave < 4) { for (int t = 0; t < nt_wg; t += 2) { ATT_STEP(t, a0, a1, b0, b1, true); ATT_STEP(t + 1, b0, b1, a0, a1, true); } }
    else          { for (int t = 0; t < nt_wg; t += 2) { ATT_STEP(t, a0, a1, b0, b1, false); ATT_STEP(t + 1, b0, b1, a0, a1, false); } }
#undef ATT_STEP
#undef ATT_DMA_K
#undef ATT_DMA_V
#undef ATT_WAITBAR
    const float l = x32_sum(l_run), inv = 1.0f / l;
#pragma unroll
    for (int d0 = 0; d0 < NV; ++d0)
#pragma unroll
        for (int r = 0; r < 16; ++r) o[d0][r] *= inv;
}

template <int NV, class Pack>
__device__ __forceinline__ void store_rows_staged(bf16_t* dst  , int ldd, LAS3 char* stg, int lane, const Pack& pack) {
    constexpr int ND = 32 * NV, PITCH = 2 * ND + 16, PPR = ND / 8;
    const int r32 = lane & 31, hi = lane >> 5;
#pragma unroll
    for (int d0 = 0; d0 < NV; ++d0)
#pragma unroll
        for (int r4 = 0; r4 < 4; ++r4) *(LAS3 u32x2*)(stg + r32 * PITCH + (32 * d0 + 8 * r4 + 4 * hi) * 2) = pack(d0, r4);
    asm volatile("s_waitcnt lgkmcnt(0)" ::: "memory");
#pragma unroll
    for (int it = 0; it < (32 * PPR) / 64; ++it) { const int idx = it * 64 + lane, row = idx / PPR, c = idx % PPR;
        const u32x4 v = *(const LAS3 u32x4*)(stg + row * PITCH + c * 16); *(u32x4*)(dst + (size_t)row * ldd + c * 8) = v; }
}
__device__ __forceinline__ void diff_unit(int b, int h, int qb, const bf16_t* P, int ldp, bf16_t* MG, const float* subln, float lam, float one_m_li, f32x4* stash  , LAS3 char* lds, int tid, int lane, int w) {
    const int r32 = lane & 31, hi = lane >> 5;
    const size_t row = (size_t)b * SEQ + qb * 256 + w * 32 + r32;
    const bf16_t* Pb = P + (size_t)b * SEQ * ldp;
    const int nt_wg = 4 * qb + 4, nt_wave = 4 * qb + (w >> 1) + 1;
    bf16x8 qf[4]; f32x16 o1[4];
#pragma unroll
    for (int j = 0; j < 4; ++j) qf[j] = *(const bf16x8*)(P + row * ldp + h * 128 + 16 * j + 8 * hi);
    sm_pass<4, 4>(o1, qf, nt_wg, nt_wave, Pb + 512 + h * 128, ldp, Pb, ldp, Pb + 1024 + h * 128, ldp, lds, w, lane);
#pragma unroll
    for (int d0 = 0; d0 < 4; ++d0)
#pragma unroll
        for (int r4 = 0; r4 < 4; ++r4) stash[(d0 * 4 + r4) * 64] = (f32x4){o1[d0][4 * r4], o1[d0][4 * r4 + 1], o1[d0][4 * r4 + 2], o1[d0][4 * r4 + 3]};
#pragma unroll
    for (int j = 0; j < 4; ++j) qf[j] = *(const bf16x8*)(P + row * ldp + h * 128 + 64 + 16 * j + 8 * hi);
    sm_pass<4, 4>(o1, qf, nt_wg, nt_wave, Pb + 512 + h * 128 + 64, ldp, Pb, ldp, Pb + 1024 + h * 128, ldp, lds, w, lane);
    float ss = 0.f;
#pragma unroll
    for (int d0 = 0; d0 < 4; ++d0)
#pragma unroll
        for (int r4 = 0; r4 < 4; ++r4) { const f32x4 a1 = stash[(d0 * 4 + r4) * 64];
#pragma unroll
            for (int e = 0; e < 4; ++e) { const float y = a1[e] - lam * o1[d0][4 * r4 + e]; o1[d0][4 * r4 + e] = y; ss += y * y; } }
    ss = x32_sum(ss);
    const float rn = one_m_li / sqrtf(ss * (1.0f / 128.0f) + 1e-6f);
    asm volatile("s_waitcnt lgkmcnt(0)\n\ts_barrier" ::: "memory");
    store_rows_staged<4>(MG + (row - r32) * 1024 + h * 128, 1024, lds + w * 8704, lane, [&](int d0, int r4) { const int d = 32 * d0 + 8 * r4 + 4 * hi; const f32x4 g = *(const f32x4*)(subln + d);
        u32x2 wv; wv.x = cvtpk(o1[d0][4 * r4] * rn * g[0], o1[d0][4 * r4 + 1] * rn * g[1]); wv.y = cvtpk(o1[d0][4 * r4 + 2] * rn * g[2], o1[d0][4 * r4 + 3] * rn * g[3]); return wv; });
}
__device__ __forceinline__ void mla_unit(int b, int h, int qb, const bf16_t* P, int ldp, const bf16_t* QB, const bf16_t* KV, bf16_t* MG, LAS3 char* lds, int tid, int lane, int w) {
    const int r32 = lane & 31, hi = lane >> 5;
    const size_t row = (size_t)b * SEQ + qb * 256 + w * 32 + r32;
    const bf16_t* Pb = P + (size_t)b * SEQ * ldp; const bf16_t* KVb = KV + (size_t)b * SEQ * 512;
    const int nt_wg = 4 * qb + 4, nt_wave = 4 * qb + (w >> 1) + 1;
    bf16x8 qf[6]; f32x16 o[2];
#pragma unroll
    for (int j = 0; j < 6; ++j) qf[j] = *(const bf16x8*)(QB + row * 512 + h * 128 + 16 * j + 8 * hi);
    sm_pass<6, 2>(o, qf, nt_wg, nt_wave, KVb + h * 128, 512, Pb + 1920, ldp, KVb + h * 128 + 64, 512, lds, w, lane);
    asm volatile("s_waitcnt lgkmcnt(0)\n\ts_barrier" ::: "memory");
    store_rows_staged<2>(MG + (row - r32) * 1024 + 512 + h * 64, 1024, lds + w * 4608, lane, [&](int d0, int r4) {
        u32x2 wv; wv.x = cvtpk(o[d0][4 * r4], o[d0][4 * r4 + 1]); wv.y = cvtpk(o[d0][4 * r4 + 2], o[d0][4 * r4 + 3]); return wv; });
}
constexpr float SB_STOP = 152.0f;
__device__ __forceinline__ void sb_unit(int b, int h, int qb32, const bf16_t* P, int ldp, bf16_t* MG, LAS3 char* vl, int lane) {
    const int r32 = lane & 31, hi = lane >> 5;
    const size_t row = (size_t)b * SEQ + qb32 * 32 + r32;
    const bf16_t* Pb = P + (size_t)b * SEQ * ldp;
    const int T = qb32 >> 1, qrel = (qb32 & 1) * 32 + r32;
    bf16x8 qf[4]; f32x16 o[2]; o[0] = f32x16{}; o[1] = f32x16{};
#pragma unroll
    for (int j = 0; j < 4; ++j) qf[j] = *(const bf16x8*)(P + row * ldp + 2048 + h * 64 + 16 * j + 8 * hi);
    const LAS3 char* vb = vl + ((lane >> 4) & 1) * 32 + (lane & 3) * 8 + (4 * hi + ((lane & 15) >> 2)) * 64;
    float R = 0.f;
    const int voffs = ((lane >> 3) * ldp + 2560 + h * 64 + (lane & 7) * 8) * 2;
    const int koffs = (r32 * ldp + 2304 + h * 64 + 8 * hi) * 2;
    u32x4 vr[8]; bf16x8 kf[4][2];
#define SB_FETCH(tt) do { const char* kt_ = (const char*)(Pb + (size_t)((tt) * 64) * ldp); \
        _Pragma("unroll") for (int it = 0; it < 8; ++it) vr[it] = *(const u32x4*)(kt_ + (size_t)(8 * it) * ldp * 2 + voffs); \
        _Pragma("unroll") for (int j = 0; j < 4; ++j) { kf[j][0] = *(const bf16x8*)(kt_ + koffs + 32 * j); kf[j][1] = *(const bf16x8*)(kt_ + (size_t)32 * ldp * 2 + koffs + 32 * j); } } while (0)
    SB_FETCH(T);
    for (int t = T; t >= 0; --t) {
        f32x16 p0 = {}, p1 = {};
#pragma unroll
        for (int j = 0; j < 4; ++j) { p0 = ATT_MFMA(kf[j][0], qf[j], p0); p1 = ATT_MFMA(kf[j][1], qf[j], p1); }
        asm volatile("s_waitcnt lgkmcnt(0)" ::: "memory");
#pragma unroll
        for (int it = 0; it < 8; ++it) { const int idx = it * 64 + lane, key = idx >> 3, c8 = idx & 7; *(LAS3 u32x4*)(vl + (c8 >> 2) * 4096 + key * 64 + (c8 & 3) * 16) = vr[it]; }
        if (t > 0) SB_FETCH(t - 1);
        const bool diag = (t == T);
        f32x16 s0, s1;
#pragma unroll
        for (int r = 0; r < 16; ++r) { const int kk = (r & 3) + 8 * (r >> 2) + 4 * hi;
            const float z0 = p0[r], z1 = p1[r];
            float a0 = fmaxf(z0, 0.f) + lg2(1.0f + ex2(-fabsf(z0))), a1 = fmaxf(z1, 0.f) + lg2(1.0f + ex2(-fabsf(z1)));
            if (diag && !(kk < qrel)) a0 = 0.f;
            if (diag && !(kk + 32 < qrel)) a1 = 0.f;
            s0[r] = a0; s1[r] = a1; }
        float own[8], oth[8];
#pragma unroll
        for (int i = 0; i < 4; ++i) { own[i] = (s0[4 * i] + s0[4 * i + 1]) + (s0[4 * i + 2] + s0[4 * i + 3]); own[4 + i] = (s1[4 * i] + s1[4 * i + 1]) + (s1[4 * i + 2] + s1[4 * i + 3]); }
#pragma unroll
        for (int i = 0; i < 8; ++i) oth[i] = x32_other(own[i], hi);
        float Aown[8]; float run = 0.f;
#pragma unroll
        for (int i = 7; i >= 0; --i) { const float Se = hi ? oth[i] : own[i], So = hi ? own[i] : oth[i];
            const float A_odd = run; run += So; const float A_even = run; run += Se;
            Aown[i] = hi ? A_odd : A_even; }
        const float tile_sum = run;
#pragma unroll
        for (int i = 0; i < 4; ++i) {
            float af0 = Aown[i] + R, af1 = Aown[4 + i] + R;
#pragma unroll
            for (int e = 3; e >= 0; --e) { const int r = 4 * i + e; const int kk = e + 8 * i + 4 * hi;
                const float sp0 = s0[r], sp1 = s1[r];
                float w0 = ex2(p0[r] - sp0 - af0), w1 = ex2(p1[r] - sp1 - af1);
                if (diag && !(kk < qrel)) w0 = 0.f;
                if (diag && !(kk + 32 < qrel)) w1 = 0.f;
                af0 += sp0; af1 += sp1; p0[r] = w0; p1[r] = w1; } }
        R += tile_sum;
        u32x4 pw[4];
#pragma unroll
        for (int i = 0; i < 4; ++i) { pw[0][i] = cvtpk(p0[2 * i], p0[2 * i + 1]); pw[1][i] = cvtpk(p0[8 + 2 * i], p0[9 + 2 * i]); pw[2][i] = cvtpk(p1[2 * i], p1[2 * i + 1]); pw[3][i] = cvtpk(p1[8 + 2 * i], p1[9 + 2 * i]); }
        asm volatile("s_waitcnt lgkmcnt(0)" ::: "memory");
#pragma unroll
        for (int d0 = 0; d0 < 2; ++d0)
#pragma unroll
            for (int ks = 0; ks < 4; ++ks) { const s16x4 lo = vtr(vb + d0 * 4096 + ks * 1024), hi4 = vtr(vb + d0 * 4096 + ks * 1024 + 512);
                o[d0] = ATT_MFMA(ATT_VFR(lo, hi4), __builtin_bit_cast(bf16x8, pw[ks]), o[d0]); }
        if (__all(R >= SB_STOP)) break;
    }
#undef SB_FETCH
    asm volatile("s_waitcnt lgkmcnt(0)" ::: "memory");
    store_rows_staged<2>(MG + (row - r32) * 1024 + 768 + h * 64, 1024, vl, lane, [&](int d0, int r4) {
        u32x2 wv; wv.x = cvtpk(o[d0][4 * r4], o[d0][4 * r4 + 1]); wv.y = cvtpk(o[d0][4 * r4 + 2], o[d0][4 * r4 + 3]); return wv; });
}
}
#define LAS __attribute__((address_space(3)))
typedef unsigned short bf16;
typedef unsigned v4u __attribute__((ext_vector_type(4)));
typedef float f32x4 __attribute__((ext_vector_type(4)));
constexpr int NWAVES = 8;
constexpr int BATCH = 8, SEQ = 4096, D = 1024, M = BATCH * SEQ, DFF = 2816, DEPTH = 2;
constexpr int NIN = 2816  , IN_SRC = 2720;
constexpr size_t MiB = 1u << 20;
constexpr size_t WS_COSD = 1 * MiB, WS_SIND = WS_COSD + 128 * 1024, WS_COSM = WS_SIND + 128 * 1024, WS_SINM = WS_COSM + 256 * 1024;
constexpr size_t WS_PART = 2 * MiB;
constexpr size_t WS_PARTQ = 4 * MiB;
constexpr size_t WS_PARTKV = 4 * MiB + 512 * 1024;
constexpr size_t WS_W = 8 * MiB, WS_WL = 42 * MiB;
constexpr size_t W_GU1 = 0, W_D1 = 11 * MiB, W_IN = W_D1 + 5632 * 1024, W_UQ = W_IN + 5632 * 1024, W_UKV = W_UQ + 256 * 1024, W_OUT = W_UKV + 256 * 1024, W_GU2 = W_OUT + 2 * MiB, W_D2 = W_GU2 + 11 * MiB;
static_assert(W_D2 + 5632 * 1024 <= WS_WL, "weight map");
constexpr size_t WS_XB = 96 * MiB;
constexpr size_t WS_MG = 160 * MiB;
constexpr size_t WS_QB = 224 * MiB;
constexpr size_t WS_KV = 256 * MiB;
constexpr size_t WS_HP = 288 * MiB;
constexpr size_t WS_STASH = 464 * MiB;
constexpr size_t WS_END = 496 * MiB;
constexpr int RING_BYTES = 131072, LDS_BYTES = 147456;

__device__ __forceinline__ unsigned f2bf(float f) { unsigned u = __builtin_bit_cast(unsigned, f); return (u + 0x7fffu + ((u >> 16) & 1u)) >> 16; }
__device__ __forceinline__ unsigned pk2(float lo, float hi) { return f2bf(lo) | (f2bf(hi) << 16); }
__device__ __forceinline__ int ropeperm(int p, int half) { return ((p >> 2) & 1) * half + 4 * (p >> 3) + (p & 3); }
__device__ __forceinline__ int src_col(int kind, int n, int nsrc, int& mat) {
    mat = 0;
    if (kind == 0) return n < nsrc ? n : -1;
    if (kind == 1) { const int pn = n >> 8, w = n & 255; mat = w >> 7; return pn * 128 + (w & 127); }
    if (kind == 2) { const int tile = n >> 8, w = n & 255;
        if (tile < 4) { const int d = n & 63; return d < 16 ? (n & ~63) + ropeperm(d, 8) : n; }
        if (tile < 7) return n;
        if (tile == 7) { if (w < 128) return 1792 + w; if (w < 160) return 1920 + ropeperm(w - 128, 16); return -1; }
        return n - 96; }
    { const int head = n >> 7, w = n & 127; if (w < 64) return head * 96 + w; if (w < 96) return head * 96 + 64 + ropeperm(w - 64, 16); return -1; }
}
__device__ __forceinline__ void wt_item(const float* W0, const float* W1, const float* gain, bf16* WT, int Ksrc, int Kdst, int Nsrc, int Ndst, int kind, LAS float* scr  , int item, int lane) {
    const int nblk = Ndst / 64, kb = item / nblk, nb = item % nblk, k0 = 64 * kb, n0 = 64 * nb;
    int mat; const int sc = src_col(kind, n0 + lane, Nsrc, mat); const float* W = mat ? W1 : W0;
    const bool live = (sc >= 0) && (k0 < Ksrc);
    const float* wp = W + (size_t)k0 * Nsrc + (live ? sc : 0);
#pragma unroll 16
    for (int kk = 0; kk < 64; ++kk) { float v = 0.f; if (live) v = wp[(size_t)kk * Nsrc]; scr[kk * 65 + lane] = v; }
    asm volatile("s_waitcnt lgkmcnt(0)" ::: "memory");
    const int c = lane & 7;
    f32x4 g0 = {1.f, 1.f, 1.f, 1.f}, g1 = {1.f, 1.f, 1.f, 1.f};
    if (gain && k0 < Ksrc) { g0 = *(const f32x4*)(gain + k0 + 8 * c); g1 = *(const f32x4*)(gain + k0 + 8 * c + 4); }
#pragma unroll
    for (int j = 0; j < 8; ++j) { const int n = (lane >> 3) + 8 * j; const LAS float* s = scr + (8 * c) * 65 + n;
        v4u o; o.x = pk2(s[0 * 65] * g0[0], s[1 * 65] * g0[1]); o.y = pk2(s[2 * 65] * g0[2], s[3 * 65] * g0[3]); o.z = pk2(s[4 * 65] * g1[0], s[5 * 65] * g1[1]); o.w = pk2(s[6 * 65] * g1[2], s[7 * 65] * g1[3]);
        *(v4u*)(WT + (size_t)(n0 + n) * Kdst + k0 + 8 * c) = o; }
    asm volatile("s_waitcnt lgkmcnt(0)" ::: "memory");
}
__device__ __forceinline__ void wt_tile(const float* W0, const float* W1, const float* gain, bf16* WT, int Ksrc, int Kdst, int Nsrc, int Ndst, int kind, LAS float* img, int tile, int wave, int lane) {
    constexpr int S = 260;
    const int nblk = Ndst / 256, kb = tile / nblk, nb = tile % nblk, k0 = 128 * kb, n0 = 256 * nb;
    int mat; const int sc = src_col(kind, n0 + 4 * lane, Nsrc, mat); const float* W = mat ? W1 : W0;
    const bool live = (sc >= 0) && (k0 < Ksrc);
    const float* wp = W + (size_t)(k0 + wave) * Nsrc + (live ? sc : 0);
    f32x4 v[16];
#pragma unroll
    for (int i = 0; i < 16; ++i) v[i] = live ? __builtin_nontemporal_load((const f32x4*)(wp + (size_t)(8 * i) * Nsrc)) : (f32x4){0.f, 0.f, 0.f, 0.f};
#pragma unroll
    for (int i = 0; i < 16; ++i) { const int kl = wave + 8 * i; const float g = (gain && k0 < Ksrc) ? gain[k0 + kl] : 1.0f; *(LAS f32x4*)(img + kl * S + 4 * lane) = v[i] * g; }
    __syncthreads();
    const int c = lane & 15, nsub = lane >> 4;
#pragma unroll
    for (int j = 0; j < 8; ++j) { const int n = 32 * j + 4 * wave + nsub; const LAS float* s = img + (8 * c) * S + n;
        v4u o; o.x = pk2(s[0 * S], s[1 * S]); o.y = pk2(s[2 * S], s[3 * S]); o.z = pk2(s[4 * S], s[5 * S]); o.w = pk2(s[6 * S], s[7 * S]);
        *(v4u*)(WT + (size_t)(n0 + n) * Kdst + k0 + 8 * c) = o; }
    __syncthreads();
}
__device__ __forceinline__ void sincos_d(float af, float& c, float& s) {
    const double a = (double)af; const double TWO_PI = 6.283185307179586476925287, INV_2PI = 0.15915494309189533576888;
    const double n = rint(a * INV_2PI); double r = a - n * TWO_PI;
    r *= 0.25; const double r2 = r * r;
    double sn = r * (1.0 + r2 * (-1.0 / 6 + r2 * (1.0 / 120 + r2 * (-1.0 / 5040 + r2 * (1.0 / 362880 + r2 * (-1.0 / 39916800 + r2 * (1.0 / 6227020800.0)))))));
    double cs = 1.0 + r2 * (-0.5 + r2 * (1.0 / 24 + r2 * (-1.0 / 720 + r2 * (1.0 / 40320 + r2 * (-1.0 / 3628800 + r2 * (1.0 / 479001600.0 + r2 * (-1.0 / 87178291200.0)))))));
#pragma unroll
    for (int i = 0; i < 2; ++i) { const double s2 = 2.0 * sn * cs, c2 = cs * cs - sn * sn; sn = s2; cs = c2; }
    c = (float)cs; s = (float)sn;
}

typedef __attribute__((address_space(1))) unsigned gu32;
#define XB_TMO      128
#define XB_XCNT(j)  (256  + 64 * (j))
#define XB_XSUB(j)  (1280 + 64 * (j))
#define XB_XGEN(j)  (2304 + 64 * (j))
#define XB_TOP      3328
#define XB_TOPGEN   3392
#define XCD_BAR_WORDS 3456
#define XB_SPIN_CAP (1u << 18)

__device__ __forceinline__ unsigned xb_ld(unsigned* p)              { return __hip_atomic_load(p, __ATOMIC_RELAXED, __HIP_MEMORY_SCOPE_AGENT); }
__device__ __forceinline__ unsigned xb_add(unsigned* p, unsigned v) { return __hip_atomic_fetch_add(p, v, __ATOMIC_RELAXED, __HIP_MEMORY_SCOPE_AGENT); }
__device__ __forceinline__ unsigned xb_xcc_id() { return (unsigned)__builtin_amdgcn_s_getreg((3 << 11) | 20) & 0xFu; }
#define XB_SPIN(cond, bar) do { unsigned _sp = 0; while (cond) { __builtin_amdgcn_s_sleep(1); \
    if ((++_sp & 255u) == 0u) { if (xb_ld(&(bar)[XB_TMO])) break; if (_sp > XB_SPIN_CAP) { atomicAdd(&(bar)[XB_TMO], 1u); break; } } } } while (0)

struct XcdBarrier {
    unsigned* bar; unsigned x;
    volatile LAS unsigned* st;
};

__device__ __forceinline__ XcdBarrier xcd_barrier_post(unsigned* bar, volatile LAS unsigned* st, bool leader) {
    XcdBarrier b; b.bar = bar; b.x = xb_xcc_id(); b.st = st;
    if (leader) (void)xb_add(&bar[XB_XCNT(b.x)], 1u);
    return b;
}
__device__ __forceinline__ void xcd_barrier_complete(unsigned* bar, unsigned x, unsigned& nloc, unsigned& nx) {
    const unsigned G = gridDim.x * gridDim.y * gridDim.z;
    unsigned sum, cnt, mine, sp = 0u;
    for (;;) {
        sum = 0u; cnt = 0u; mine = 0u;
#pragma unroll
        for (unsigned j = 0; j < 16; ++j) { const unsigned c = xb_ld(&bar[XB_XCNT(j)]); sum += c; cnt += (c > 0u) ? 1u : 0u; mine = (j == x) ? c : mine; }
        if (sum == G) break;
        __builtin_amdgcn_s_sleep(1);
        if ((++sp & 255u) == 0u) { if (xb_ld(&bar[XB_TMO])) break; if (sp > XB_SPIN_CAP) { atomicAdd(&bar[XB_TMO], 1u); break; } }
    }
    nloc = mine > 0u ? mine : 1u; nx = cnt > 0u ? cnt : 1u;
}

__device__ __forceinline__ void xcd_barrier(const XcdBarrier& b, bool leader) {
    asm volatile("s_waitcnt vmcnt(0)" ::: "memory");
    __syncthreads();
    if (leader) {
        unsigned* bar = b.bar;
        __builtin_amdgcn_s_waitcnt(0);
        unsigned nloc = b.st[0], nx = b.st[1];
        if (nloc == 0u) { xcd_barrier_complete(bar, b.x, nloc, nx); b.st[0] = nloc; b.st[1] = nx; }
        const unsigned old = xb_add(&bar[XB_XSUB(b.x)], 1u);
        const unsigned gen = old / nloc;
        if (old + 1u == (gen + 1u) * nloc) {
            __builtin_amdgcn_fence(__ATOMIC_RELEASE, "agent");
            asm volatile("s_waitcnt vmcnt(0)" ::: "memory");
            const unsigned og = xb_add(&bar[XB_TOP], 1u);
            const unsigned tg = og / nx;
            if (og + 1u == (tg + 1u) * nx) xb_add(&bar[XB_TOPGEN], 1u);
            else XB_SPIN(xb_ld(&bar[XB_TOPGEN]) == tg, bar);
            __builtin_amdgcn_fence(__ATOMIC_ACQUIRE, "agent");
            xb_add(&bar[XB_XGEN(b.x)], 1u);
            asm volatile("s_waitcnt vmcnt(0)" ::: "memory");
        } else {
            XB_SPIN(xb_ld(&bar[XB_XGEN(b.x)]) == gen, bar);
            __builtin_amdgcn_fence(__ATOMIC_ACQUIRE, "agent");
            asm volatile("s_waitcnt vmcnt(0)" ::: "memory");
        }
    }
    __syncthreads();
}


struct Args { const float* in[22]; float* out; unsigned char* ws; };

__global__ void __launch_bounds__(NWAVES * 64, 2) fwd_mega(Args a) {
    extern __shared__ __attribute__((aligned(16))) unsigned char lds_raw[];
    cg::grid_group grid = cg::this_grid();
    LAS unsigned char* lds = (LAS unsigned char*)lds_raw;
    const int wave = __builtin_amdgcn_readfirstlane((int)threadIdx.x >> 6);
#define FRESH_LANE() ({ unsigned m_ = ~0u; asm volatile("" : "+s"(m_)); int l_ = (int)__builtin_amdgcn_mbcnt_hi(m_, __builtin_amdgcn_mbcnt_lo(m_, 0u)); l_; })
    volatile LAS unsigned* MISC = (volatile LAS unsigned*)(lds + RING_BYTES + 15360);
    { const int ln0 = FRESH_LANE(); if (wave == 0 && ln0 < 2) MISC[ln0] = 0u;
      if (blockIdx.x == 0) { unsigned* bw = (unsigned*)a.ws; for (int i = wave * 64 + ln0; i < XCD_BAR_WORDS; i += NWAVES * 64) bw[i] = 0u; } }
    __syncthreads();
    const int G = gridDim.x, bx = blockIdx.x; const int vcu = (G % 8 == 0) ? (bx % 8) * (G / 8) + bx / 8 : bx;
#define LOCALS() \
    int z_ = 0; asm volatile("" : "+s"(z_)); const float* const* in = a.in + z_; \
    unsigned char* ws = a.ws + z_; float* out = a.out + z_; const float* x = in[0]; \
    float* cosd = (float*)(ws + WS_COSD); float* sind = (float*)(ws + WS_SIND); float* cosm = (float*)(ws + WS_COSM); float* sinm = (float*)(ws + WS_SINM); \
    float* part = (float*)(ws + WS_PART); float* partq = (float*)(ws + WS_PARTQ); float* partkv = (float*)(ws + WS_PARTKV); \
    bf16* XB = (bf16*)(ws + WS_XB); bf16* MG = (bf16*)(ws + WS_MG); bf16* QB = (bf16*)(ws + WS_QB); bf16* KV = (bf16*)(ws + WS_KV); bf16* HP = (bf16*)(ws + WS_HP); \
    (void)x; (void)out; (void)cosd; (void)sind; (void)cosm; (void)sinm; (void)part; (void)partq; (void)partkv; (void)XB; (void)MG; (void)QB; (void)KV; (void)HP
    const int gw = vcu * NWAVES + wave, NGW = G * NWAVES;

    {
        LOCALS();
        const int lane = FRESH_LANE(), tid = wave * 64 + lane;
        LAS float* scr = (LAS float*)(lds + wave * 16640);
        constexpr int I_GU = 16 * 88, I_D = 44 * 16, I_IN = 16 * 44, I_UQ = 4 * 8, I_UKV = 4 * 8, I_OUT = 16 * 16;
        constexpr int I_LAYER = 2 * I_GU + 2 * I_D + I_IN + I_UQ + I_UKV + I_OUT;
        constexpr int T_GU = 8 * 22, T_D = 22 * 4, T_IN = 8 * 11, T_UQ = 2 * 2, T_UKV = 2 * 2, T_OUT = 8 * 4, T_LAYER = 2 * T_GU + 2 * T_D + T_IN + T_UQ + T_UKV + T_OUT;
        LAS float* img = (LAS float*)lds;
        for (int tl = vcu; tl < DEPTH * T_LAYER; tl += G) {
            const int l = tl / T_LAYER; int r = tl % T_LAYER; bf16* wl = (bf16*)(ws + WS_W + l * WS_WL);
            if (r < T_GU) { wt_tile(in[2] + (size_t)l * D * DFF, in[3] + (size_t)l * D * DFF, in[1] + l * D, (bf16*)((char*)wl + W_GU1), D, D, DFF, 2 * DFF, 1, img, r, wave, lane); continue; } r -= T_GU;
            if (r < T_D) { wt_tile(in[4] + (size_t)l * DFF * D, nullptr, nullptr, (bf16*)((char*)wl + W_D1), DFF, DFF, D, D, 0, img, r, wave, lane); continue; } r -= T_D;
            if (r < T_IN) { wt_tile(in[6] + (size_t)l * D * IN_SRC, nullptr, in[5] + l * D, (bf16*)((char*)wl + W_IN), D, D, IN_SRC, NIN, 2, img, r, wave, lane); continue; } r -= T_IN;
            if (r < T_UQ) { wt_tile(in[13] + (size_t)l * 256 * 384, nullptr, in[12] + l * 256, (bf16*)((char*)wl + W_UQ), 256, 256, 384, 512, 3, img, r, wave, lane); continue; } r -= T_UQ;
            if (r < T_UKV) { wt_tile(in[15] + (size_t)l * 128 * 512, nullptr, in[14] + l * 128, (bf16*)((char*)wl + W_UKV), 128, 256, 512, 512, 0, img, r, wave, lane); continue; } r -= T_UKV;
            if (r < T_OUT) { wt_tile(in[16] + (size_t)l * D * D, nullptr, nullptr, (bf16*)((char*)wl + W_OUT), D, D, D, D, 0, img, r, wave, lane); continue; } r -= T_OUT;
            if (r < T_GU) { wt_tile(in[18] + (size_t)l * D * DFF, in[19] + (size_t)l * D * DFF, in[17] + l * D, (bf16*)((char*)wl + W_GU2), D, D, DFF, 2 * DFF, 1, img, r, wave, lane); continue; } r -= T_GU;
            wt_tile(in[20] + (size_t)l * DFF * D, nullptr, nullptr, (bf16*)((char*)wl + W_D2), DFF, DFF, D, D, 0, img, r, wave, lane);
        }
        for (int i = bx * 512 + tid; i < SEQ * 24; i += G * 512) {
            const int pos = i / 24, k = i % 24; float c, s;
            if (k < 8) { const float inv = (float)exp2(-(double)(2 * k) / 16.0 * 18.931568569324174  ); sincos_d((float)pos * inv, c, s); cosd[pos * 8 + k] = c; sind[pos * 8 + k] = s; }
            else { const int kk = k - 8; const float inv = (float)exp2(-(double)(2 * kk) / 32.0 * 18.931568569324174); sincos_d((float)pos * inv, c, s); cosm[pos * 16 + kk] = c; sinm[pos * 16 + kk] = s; }
        }
        for (int m0 = gw * 4; m0 < M; m0 += NGW * 4) {
            f32x4 v[4][4]; float s[4];
#pragma unroll
            for (int r = 0; r < 4; ++r) { const f32x4* xr = (const f32x4*)(x + (size_t)(m0 + r) * D) + lane;
#pragma unroll
                for (int j = 0; j < 4; ++j) v[r][j] = __builtin_nontemporal_load(xr + 64 * j); }
#pragma unroll
            for (int r = 0; r < 4; ++r) { float t = 0.f;
#pragma unroll
                for (int j = 0; j < 4; ++j) t += (v[r][j].x * v[r][j].x + v[r][j].y * v[r][j].y) + (v[r][j].z * v[r][j].z + v[r][j].w * v[r][j].w);
                s[r] = wave_sum(t); }
#pragma unroll
            for (int r = 0; r < 4; ++r) { unsigned long long* o8 = (unsigned long long*)(XB + (size_t)(m0 + r) * D) + lane;
#pragma unroll
                for (int j = 0; j < 4; ++j) o8[64 * j] = (unsigned long long)pk2(v[r][j].x, v[r][j].y) | ((unsigned long long)pk2(v[r][j].z, v[r][j].w) << 32); }
            { const int r = lane >> 4, c = lane & 15; const float sv = r == 0 ? s[0] : r == 1 ? s[1] : r == 2 ? s[2] : s[3]; part[(size_t)(m0 + r) * 16 + c] = c == 0 ? sv : 0.f; }
        }
    }
    grid.sync();
    XcdBarrier bar = xcd_barrier_post((unsigned*)a.ws, MISC, wave == 0 && FRESH_LANE() == 0);

    const float QS64 = 0.125f * 1.4426950408889634f, QS96 = 0.10206207261596575f * 1.4426950408889634f;
    for (int st = 0; st < DEPTH * 8; ++st) {
        LOCALS();
        const int l = st >> 3, k = st & 7;
        const unsigned char* wl = ws + WS_W + (size_t)l * WS_WL;
        if (0) {}
#ifndef NO_UP
        else if (k == 0 || k == 6) {
            pg8::Gemm g{XB, (const bf16*)(wl + (k == 0 ? W_GU1 : W_GU2)), M, 2 * DFF, D, D, D}; pg8::StaticOrder S; S.init(M, 2 * DFF, G, bx);
            LAS float* rst = (LAS float*)(lds + RING_BYTES); pg8::fill_rowscale<16>(rst, S, part, 1.0f / 1024.0f, 1.0f, wave * 64 + FRESH_LANE());
            pg8::EpiUp E{HP, rst, DFF};
            pg8::gemm_phase<pg8::EpiUp, pg8::StaticOrder, true, true>(lds, g, S, E, wave);
        }
#endif
#ifndef NO_RES
        else if (k == 1 || k == 7 || k == 5) {
            const bool wo = (k == 5);
            pg8::Gemm g{wo ? MG : HP, (const bf16*)(wl + (k == 1 ? W_D1 : k == 7 ? W_D2 : W_OUT)), M, D, wo ? D : DFF, wo ? D : DFF, wo ? D : DFF}; pg8::StaticOrder S; S.init(M, D, G, bx);
            pg8::EpiRes E{XB, part, wo ? 1.0f : 0.5f};
            pg8::gemm_phase<pg8::EpiRes, pg8::StaticOrder, true, true>(lds, g, S, E, wave);
        }
#endif
#ifndef NO_IN
        else if (k == 2) {
            pg8::Gemm g{XB, (const bf16*)(wl + W_IN), M, NIN, D, D, D}; pg8::StaticOrder S; S.init(M, NIN, G, bx);
            LAS float* rst = (LAS float*)(lds + RING_BYTES); pg8::fill_rowscale<16>(rst, S, part, 1.0f / 1024.0f, 1.0f, wave * 64 + FRESH_LANE());
            pg8::EpiIn E{HP, rst, partq, partkv, cosd, sind, cosm, sinm, NIN, QS64};
            pg8::gemm_phase<pg8::EpiIn, pg8::StaticOrder, true, true>(lds, g, S, E, wave);
        }
#endif
#ifndef NO_MLA
        else if (k == 3) {
            { pg8::Gemm g{HP + 6 * 256, (const bf16*)(wl + W_UQ), M, 512, 256, NIN, 256}; pg8::StaticOrder S; S.init(M, 512, G, bx);
              LAS float* rst = (LAS float*)(lds + RING_BYTES); pg8::fill_rowscale<4>(rst, S, partq, 1.0f / 256.0f, QS96, wave * 64 + FRESH_LANE());
              pg8::EpiMla<true> E{QB, rst, cosm, sinm, 512};
              pg8::gemm_phase<pg8::EpiMla<true>, pg8::StaticOrder, true, true>(lds, g, S, E, wave); }
            { pg8::Gemm g{HP + 7 * 256, (const bf16*)(wl + W_UKV), M, 512, 256, NIN, 256}; pg8::StaticOrder S; S.init(M, 512, G, bx);
              LAS float* rst = (LAS float*)(lds + RING_BYTES) + 1024; pg8::fill_rowscale<4>(rst, S, partkv, 1.0f / 128.0f, 1.0f, wave * 64 + FRESH_LANE());
              pg8::EpiMla<false> E{KV, rst, cosm, sinm, 512};
              pg8::gemm_phase<pg8::EpiMla<false>, pg8::StaticOrder, true, true>(lds, g, S, E, wave); }
        }
#endif
#ifndef NO_ATT
        else {
            const float li = 0.8f - 0.6f * expf(-0.3f * (float)l);
            const int lane = FRESH_LANE();
            float v1 = in[7][l * 64 + lane] * in[8][l * 64 + lane], v2 = in[9][l * 64 + lane] * in[10][l * 64 + lane];
            v1 = wave_sum(v1); v2 = wave_sum(v2);
            const float lam = expf(v1) - expf(v2) + li;
            const float* subln = in[11] + l * 128;
            for (int pr = vcu; pr < 256; pr += G) { const int bh = pr >> 3, s = pr & 7, b = bh >> 2, h = bh & 3;
#ifndef NO_DIFF
#pragma clang loop unroll(disable)
                for (int rep = 0; rep < 2; ++rep) { const int ln = FRESH_LANE();
                    f32x4* stash = (f32x4*)(ws + WS_STASH) + ((size_t)(bx * NWAVES + wave) * 16) * 64 + ln;
                    att::diff_unit(b, h, rep ? 15 - s : s, HP, NIN, MG, subln, lam, 1.0f - li, stash, (LAS char*)lds, wave * 64 + ln, ln, wave); }
#endif
#ifndef NO_MLAU
#pragma clang loop unroll(disable)
                for (int rep = 0; rep < 2; ++rep) { const int ln = FRESH_LANE();
                    att::mla_unit(b, h, rep ? 15 - s : s, HP, NIN, QB, KV, MG, (LAS char*)lds, wave * 64 + ln, ln, wave); }
#endif
            }
            __syncthreads();
#ifndef NO_SB
#pragma clang loop unroll(disable)
            for (int u = bx * NWAVES + wave; u < BATCH * 4 * 128; u += NGW) { const int b = u >> 9, h = (u >> 7) & 3, qb32 = u & 127; const int ln = FRESH_LANE();
                att::sb_unit(b, h, qb32, HP, NIN, MG, (LAS char*)lds + att::LDS_SBV + wave * 8192, ln); }
#endif
            __syncthreads();
        }
#endif
        xcd_barrier(bar, wave == 0 && FRESH_LANE() == 0);
    }
    {
        LOCALS();
        const int lane = FRESH_LANE();
        const float* gn = in[21];
        f32x4 g4[2][2];
#pragma unroll
        for (int j = 0; j < 2; ++j) { g4[j][0] = *(const f32x4*)(gn + 8 * lane + 512 * j); g4[j][1] = *(const f32x4*)(gn + 8 * lane + 512 * j + 4); }
        for (int m0 = gw * 4; m0 < M; m0 += NGW * 4) {
            v4u raw[4][2];
#pragma unroll
            for (int r = 0; r < 4; ++r)
#pragma unroll
                for (int j = 0; j < 2; ++j) raw[r][j] = __builtin_nontemporal_load((const v4u*)(XB + (size_t)(m0 + r) * D + 8 * lane + 512 * j));
#pragma unroll
            for (int r = 0; r < 4; ++r) { f32x4 v[2][2]; float t = 0.f;
#pragma unroll
                for (int j = 0; j < 2; ++j) { const v4u w = raw[r][j];
                    v[j][0] = (f32x4){__builtin_bit_cast(float, w.x << 16), __builtin_bit_cast(float, w.x & 0xffff0000u), __builtin_bit_cast(float, w.y << 16), __builtin_bit_cast(float, w.y & 0xffff0000u)};
                    v[j][1] = (f32x4){__builtin_bit_cast(float, w.z << 16), __builtin_bit_cast(float, w.z & 0xffff0000u), __builtin_bit_cast(float, w.w << 16), __builtin_bit_cast(float, w.w & 0xffff0000u)};
                    t += (v[j][0].x * v[j][0].x + v[j][0].y * v[j][0].y) + (v[j][0].z * v[j][0].z + v[j][0].w * v[j][0].w) + (v[j][1].x * v[j][1].x + v[j][1].y * v[j][1].y) + (v[j][1].z * v[j][1].z + v[j][1].w * v[j][1].w); }
                const float rs = 1.0f / sqrtf(wave_sum(t) * (1.0f / D) + 1e-6f);
                float* xo = out + (size_t)(m0 + r) * D + 8 * lane;
#pragma unroll
                for (int j = 0; j < 2; ++j) { __builtin_nontemporal_store(v[j][0] * rs * g4[j][0], (f32x4*)(xo + 512 * j)); __builtin_nontemporal_store(v[j][1] * rs * g4[j][1], (f32x4*)(xo + 512 * j + 4)); } }
        }
    }
}

extern "C" void kernel_launch(void* const* d_in, const int* in_sizes, int n_in, void* d_out, int out_size, void* d_ws, size_t ws_size, hipStream_t stream) {
    static int grid = 0;
    if (grid == 0) {
        if (n_in != 22 || ws_size < WS_END) { fprintf(stderr, "kernel_launch: unexpected n_in %d / ws %zu\n", n_in, ws_size); grid = -1; return; }
        int dev = 0, cus = 0, per_cu = 0;
        (void)hipGetDevice(&dev); (void)hipDeviceGetAttribute(&cus, hipDeviceAttributeMultiprocessorCount, dev);
        (void)hipFuncSetAttribute((const void*)fwd_mega, hipFuncAttributeMaxDynamicSharedMemorySize, LDS_BYTES);
        (void)hipOccupancyMaxActiveBlocksPerMultiprocessor(&per_cu, (const void*)fwd_mega, NWAVES * 64, LDS_BYTES);
        if (per_cu < 1) { fprintf(stderr, "kernel_launch: occupancy query says %d blocks per CU\n", per_cu); per_cu = 1; }
        (void)hipGetLastError();
        grid = cus * per_cu;
    }
    if (grid < 0) return;
    Args a{};
    for (int i = 0; i < 22; ++i) a.in[i] = (const float*)d_in[i];
    a.out = (float*)d_out; a.ws = (unsigned char*)d_ws;
    void* args[] = {&a};
    hipError_t e = hipLaunchCooperativeKernel((const void*)fwd_mega, dim3(grid), dim3(NWAVES * 64), args, LDS_BYTES, stream);
    if (e != hipSuccess) fprintf(stderr, "cooperative launch failed: %s (grid %d)\n", hipGetErrorString(e), grid);
}
```
